# Optimizing an MI355X kernel written in HIP

```python
import jax, jax.numpy as jnp
from jax import lax
import numpy as np

D_MODEL = 2048
BATCH = 8
SEQ = 2048
DEPTH = 2
DEC_BATCH = 32
DEC_SEQ = 64
PAST_LEN = 1024

CHUNK = 64
N_META = 16
EPS = 1e-6

MLSTM_H = 8
MLSTM_DH = 128
MLSTM_W = MLSTM_H * MLSTM_DH
HGRN_H = 4
HGRN_DK = 128
HGRN_DV = 128
HGRN_W = HGRN_H * HGRN_DV
RWKV_H = 8
RWKV_DH = 64
RWKV_W = RWKV_H * RWKV_DH
RWKV_RANK_W = 64
RWKV_RANK_A = 64
RWKV_GN_EPS = 64e-5
N_BRANCH = 3

A_SIZES = (MLSTM_W, MLSTM_W, MLSTM_W, MLSTM_H, MLSTM_H, MLSTM_W, MLSTM_W)
B_SIZES = (HGRN_H * HGRN_DK, HGRN_H * HGRN_DK, HGRN_W, HGRN_W)
C_SIZES = (RWKV_W, RWKV_W, RWKV_W, RWKV_RANK_W, RWKV_RANK_A, RWKV_W)
G_SIZES = (D_MODEL,) * N_BRANCH
A_COLS = sum(A_SIZES)
B_COLS = sum(B_SIZES)
C_COLS = sum(C_SIZES)
G_COLS = sum(G_SIZES)
N_IN = A_COLS + B_COLS + C_COLS + G_COLS

kernel_name = 'hybrid_mlstm_hgrn2_rwkv7_stream_step'


def f32(a):
    return a.astype(jnp.float32)


def split_cols(p, sizes):
    idx = [int(i) for i in np.cumsum(sizes)[:-1]]
    return jnp.split(p, idx, axis=-1)


def rmsnorm(x, g):
    xf = f32(x)
    y = xf * lax.rsqrt(jnp.mean(xf * xf, axis=-1, keepdims=True) + EPS)
    return (y * f32(g)).astype(x.dtype)


def heads_first(a, n_heads):
    b, t, _ = a.shape
    return a.reshape(b, t, n_heads, -1).transpose(0, 2, 1, 3)


def to_chunks(a, length):
    b, h, t = a.shape[:3]
    a = a.reshape((b, h, t // length, length) + a.shape[3:])
    return jnp.moveaxis(a, 2, 0)


def from_chunks(a):
    a = jnp.moveaxis(a, 0, 2)
    return a.reshape(a.shape[:2] + (-1,) + a.shape[4:])


def run_segments(step, state, xs, segments):
    outs = []
    for t0, t1, length in segments:
        seg = tuple(to_chunks(a[:, :, t0:t1], length) for a in xs)
        state, out = lax.scan(step, state, seg)
        outs.append(from_chunks(out))
    return state, jnp.concatenate(outs, axis=2)


def mlstm_step(carry, inp):
    c, n, m = carry
    q, k, v, ig, lf = inp
    length = q.shape[2]
    causal = jnp.tril(jnp.ones((length, length), dtype=bool))
    b = jnp.cumsum(lf, axis=-1)
    d = jnp.where(causal, b[..., :, None] - b[..., None, :] + ig[..., None, :], -jnp.inf)
    inter = b + m[..., None]
    m_t = jnp.maximum(inter, jnp.max(d, axis=-1))
    w_inter = jnp.exp(inter - m_t)
    s = jnp.einsum('bhtk,bhsk->bhts', q, k) * jnp.exp(d - m_t[..., None])
    num = w_inter[..., None] * jnp.einsum('bhvk,bhtk->bhtv', c, q) + jnp.einsum('bhts,bhsv->bhtv', s, v)
    den = w_inter * jnp.einsum('bhk,bhtk->bht', n, q) + jnp.sum(s, axis=-1)
    h = num / jnp.maximum(jnp.abs(den), jnp.exp(-m_t))[..., None]
    b_end = b[..., -1]
    g = b_end[..., None] - b + ig
    m_new = jnp.maximum(b_end + m, jnp.max(g, axis=-1))
    w_old = jnp.exp(b_end + m - m_new)
    w_s = jnp.exp(g - m_new[..., None])
    c_new = w_old[..., None, None] * c + jnp.einsum('bhs,bhsv,bhsk->bhvk', w_s, v, k)
    n_new = w_old[..., None] * n + jnp.einsum('bhs,bhsk->bhk', w_s, k)
    return (c_new, n_new, m_new), h


def hgrn_step(s_state, inp):
    q, k, v, lf = inp
    length = q.shape[2]
    causal = jnp.tril(jnp.ones((length, length), dtype=bool))[:, :, None]
    a = jnp.cumsum(lf, axis=2)
    rel = jnp.where(causal, a[:, :, :, None, :] - a[:, :, None, :, :], -jnp.inf)
    scores = jnp.einsum('bhtk,bhsk,bhtsk->bhts', q, k, jnp.exp(rel))
    o = jnp.einsum('bhtk,bhkv->bhtv', q * jnp.exp(a), s_state) + jnp.einsum('bhts,bhsv->bhtv', scores, v)
    a_end = a[:, :, -1:]
    s_new = jnp.exp(a_end[:, :, 0])[..., None] * s_state + jnp.einsum('bhsk,bhsv->bhkv', k * jnp.exp(a_end - a), v)
    return s_new, o


def rwkv_step(s_state, inp):
    r, w, k, v, kk, a = inp
    sa = jnp.einsum('bhvk,bhk->bhv', s_state, -kk)
    s_new = (s_state * w[:, :, None, :] + sa[..., None] * (kk * a)[:, :, None, :]
             + v[..., None] * k[:, :, None, :])
    y = jnp.einsum('bhvk,bhk->bhv', s_new, r)
    return s_new, y


def mlstm_branch(pa, p, state, segments):
    bsz, t, _ = pa.shape
    q, k, v, ig, fg, og, z = split_cols(f32(pa), A_SIZES)
    q = heads_first(q, MLSTM_H)
    k = heads_first(k, MLSTM_H) * (MLSTM_DH ** -0.5)
    v = heads_first(v, MLSTM_H)
    ig = (ig + p['mlstm_b_i']).transpose(0, 2, 1)
    lf = jax.nn.log_sigmoid(fg + p['mlstm_b_f']).transpose(0, 2, 1)
    state, h = run_segments(mlstm_step, tuple(f32(s) for s in state), (q, k, v, ig, lf), segments)
    h = h.transpose(0, 2, 1, 3)
    mu = jnp.mean(h, axis=-1, keepdims=True)
    var = jnp.mean(jnp.square(h - mu), axis=-1, keepdims=True)
    h = ((h - mu) * lax.rsqrt(var + EPS)).reshape(bsz, t, MLSTM_W) * p['mlstm_norm']
    return h * jax.nn.sigmoid(og) * jax.nn.silu(z), state


def hgrn_branch(pb, p, lb, s_state, segments):
    bsz, t, _ = pb.shape
    q, fp, i, z = split_cols(f32(pb), B_SIZES)
    f = lb + (1.0 - lb) * jax.nn.sigmoid(fp)
    lf = heads_first(jnp.log(f), HGRN_H)
    k = heads_first((1.0 - lb) * jax.nn.sigmoid(-fp), HGRN_H)
    s_state, o = run_segments(hgrn_step, f32(s_state),
                              (heads_first(q, HGRN_H), k, heads_first(i, HGRN_H), lf), segments)
    o = o.transpose(0, 2, 1, 3)
    o = o * lax.rsqrt(jnp.mean(o * o, axis=-1, keepdims=True) + EPS)
    return o.reshape(bsz, t, HGRN_W) * p['hgrn_norm'] * jax.nn.silu(z), s_state


def rwkv_branch(pc, p, shift, s_state):
    pc = f32(pc)
    bsz, t, _ = pc.shape
    prev = jnp.concatenate([f32(shift), pc[:, :-1]], axis=1)
    xs = pc + p['rwkv_mu'] * (prev - pc)
    r, k, v, wd, ad, z = split_cols(xs, C_SIZES)
    w_logit = -jax.nn.softplus(-(p['rwkv_w0'] + jnp.tanh(wd) @ p['rwkv_w_up'])) - 0.5
    decay = jnp.exp(-jnp.exp(w_logit))
    a = jax.nn.sigmoid(p['rwkv_a0'] + ad @ p['rwkv_a_up'])

    def split_h(u):
        return u.reshape(bsz, t, RWKV_H, RWKV_DH)

    def time_major(u):
        return u.transpose(1, 0, 2, 3)

    kk = split_h(k * p['rwkv_k_k'])
    kk = kk / jnp.maximum(jnp.sqrt(jnp.sum(kk * kk, axis=-1, keepdims=True)), 1e-12)
    k = k * (1.0 + (a - 1.0) * p['rwkv_k_a'])
    r, k, v, decay, a = (split_h(u) for u in (r, k, v, decay, a))
    s_state, y = lax.scan(rwkv_step, f32(s_state), tuple(time_major(u) for u in (r, decay, k, v, kk, a)))
    y = time_major(y)
    mu = jnp.mean(y, axis=-1, keepdims=True)
    var = jnp.mean(jnp.square(y - mu), axis=-1, keepdims=True)
    y = ((y - mu) * lax.rsqrt(var + RWKV_GN_EPS) * p['rwkv_gn_g'].reshape(RWKV_H, RWKV_DH)
         + p['rwkv_gn_b'].reshape(RWKV_H, RWKV_DH))
    bonus = jnp.sum(r * k * p['rwkv_r_k'].reshape(RWKV_H, RWKV_DH), axis=-1, keepdims=True) * v
    out = (y + bonus).reshape(bsz, t, RWKV_W) * jax.nn.silu(z)
    return out, pc[:, -1:], s_state


def layer(x, p, lb, state, segments):
    c, n, m, s_h, s_r, shift = state
    h = rmsnorm(x, p['norm_pre'])
    proj = h @ p['w_in']
    pa, pb, pc, pg = split_cols(proj, (A_COLS, B_COLS, C_COLS, G_COLS))
    ya, (c, n, m) = mlstm_branch(pa, p, (c, n, m), segments)
    yb, s_h = hgrn_branch(pb, p, lb, s_h, segments)
    yc, shift, s_r = rwkv_branch(pc, p, shift, s_r)
    ga, gb, gc = split_cols(jax.nn.sigmoid(f32(pg)), G_SIZES)
    dt = h.dtype
    merged = (ga * (ya.astype(dt) @ p['w_proj_a']) + gb * (yb.astype(dt) @ p['w_proj_b'])
              + gc * (yc.astype(dt) @ p['w_proj_c']))
    y = merged.astype(dt) @ p['w_out']
    return x + rmsnorm(y, p['norm_post']), (c, n, m, s_h, s_r, shift)


def setup_inputs(seed: int = 0) -> dict:
    key = jax.random.key(seed)
    ks = jax.random.split(key, 40)

    def nrm(i, shape, scale=1.0):
        return scale * jax.random.normal(ks[i], shape, jnp.float32)

    return {
        'x_prompt': nrm(0, (BATCH, SEQ, D_MODEL)),
        'x_sample': nrm(1, (DEC_BATCH, DEC_SEQ, D_MODEL)),
        'state_mlstm_C': nrm(2, (DEPTH, DEC_BATCH, MLSTM_H, MLSTM_DH, MLSTM_DH), 0.5),
        'state_mlstm_n': nrm(3, (DEPTH, DEC_BATCH, MLSTM_H, MLSTM_DH), 0.5),
        'state_mlstm_m': nrm(4, (DEPTH, DEC_BATCH, MLSTM_H), 0.5),
        'state_hgrn_S': nrm(5, (DEPTH, DEC_BATCH, HGRN_H, HGRN_DK, HGRN_DV), 0.5),
        'state_rwkv_S': nrm(6, (DEPTH, DEC_BATCH, RWKV_H, RWKV_DH, RWKV_DH), 0.5),
        'cache_rwkv_shift': nrm(7, (DEPTH, DEC_BATCH, 1, C_COLS)),
        'meta_tokens': nrm(8, (N_META, D_MODEL)),
        'norm_pre': 1.0 + nrm(9, (DEPTH, D_MODEL), 0.05),
        'norm_post': 1.0 + nrm(10, (DEPTH, D_MODEL), 0.05),
        'w_in': nrm(11, (DEPTH, D_MODEL, N_IN), D_MODEL ** -0.5),
        'mlstm_b_i': nrm(12, (DEPTH, MLSTM_H), 0.1),
        'mlstm_b_f': 3.0 + nrm(13, (DEPTH, MLSTM_H), 0.5),
        'mlstm_norm': 1.0 + nrm(14, (DEPTH, MLSTM_W), 0.05),
        'hgrn_lb_logits': nrm(15, (DEPTH, HGRN_H * HGRN_DK), 0.5),
        'hgrn_norm': 1.0 + nrm(16, (DEPTH, HGRN_W), 0.05),
        'rwkv_mu': jax.random.uniform(ks[17], (DEPTH, C_COLS), jnp.float32),
        'rwkv_w0': -2.0 + nrm(18, (DEPTH, RWKV_W), 0.5),
        'rwkv_w_up': nrm(19, (DEPTH, RWKV_RANK_W, RWKV_W), 0.5 * RWKV_RANK_W ** -0.5),
        'rwkv_a0': nrm(20, (DEPTH, RWKV_W), 0.1),
        'rwkv_a_up': nrm(21, (DEPTH, RWKV_RANK_A, RWKV_W), 0.5 * RWKV_RANK_A ** -0.5),
        'rwkv_k_k': 0.85 + nrm(22, (DEPTH, RWKV_W), 0.05),
        'rwkv_k_a': 1.0 + nrm(23, (DEPTH, RWKV_W), 0.05),
        'rwkv_r_k': nrm(24, (DEPTH, RWKV_W), 0.1),
        'rwkv_gn_g': 1.0 + nrm(25, (DEPTH, RWKV_W), 0.05),
        'rwkv_gn_b': nrm(26, (DEPTH, RWKV_W), 0.01),
        'w_proj_a': nrm(27, (DEPTH, MLSTM_W, D_MODEL), MLSTM_W ** -0.5),
        'w_proj_b': nrm(28, (DEPTH, HGRN_W, D_MODEL), HGRN_W ** -0.5),
        'w_proj_c': nrm(29, (DEPTH, RWKV_W, D_MODEL), RWKV_W ** -0.5),
        'w_out': nrm(30, (DEPTH, D_MODEL, D_MODEL), D_MODEL ** -0.5),
    }


def reference(x_prompt, x_sample, state_mlstm_C, state_mlstm_n, state_mlstm_m, state_hgrn_S,
              state_rwkv_S, cache_rwkv_shift, meta_tokens, norm_pre, norm_post, w_in,
              mlstm_b_i, mlstm_b_f, mlstm_norm, hgrn_lb_logits, hgrn_norm, rwkv_mu, rwkv_w0,
              rwkv_w_up, rwkv_a0, rwkv_a_up, rwkv_k_k, rwkv_k_a, rwkv_r_k, rwkv_gn_g, rwkv_gn_b,
              w_proj_a, w_proj_b, w_proj_c, w_out):
    bp, t_p, _ = x_prompt.shape
    t_s = x_sample.shape[1]
    sm = jax.nn.softmax(f32(hgrn_lb_logits), axis=0)
    lb_all = jnp.cumsum(sm, axis=0) - sm[0]

    meta = jnp.broadcast_to(meta_tokens.astype(x_prompt.dtype)[None], (bp, N_META, D_MODEL))
    x_p = jnp.concatenate([meta, x_prompt], axis=1)
    x_s = x_sample
    seg_p = ((0, N_META, N_META), (N_META, N_META + t_p, CHUNK))
    seg_s = ((0, t_s, t_s),)
    init_p = (jnp.zeros((bp, MLSTM_H, MLSTM_DH, MLSTM_DH), jnp.float32),
              jnp.zeros((bp, MLSTM_H, MLSTM_DH), jnp.float32),
              jnp.zeros((bp, MLSTM_H), jnp.float32),
              jnp.zeros((bp, HGRN_H, HGRN_DK, HGRN_DV), jnp.float32),
              jnp.zeros((bp, RWKV_H, RWKV_DH, RWKV_DH), jnp.float32),
              jnp.zeros((bp, 1, C_COLS), jnp.float32))
    outs_p = []
    outs_s = []
    for l in range(DEPTH):
        p = {
            'norm_pre': norm_pre[l], 'norm_post': norm_post[l], 'w_in': w_in[l],
            'mlstm_b_i': f32(mlstm_b_i[l]), 'mlstm_b_f': f32(mlstm_b_f[l]), 'mlstm_norm': f32(mlstm_norm[l]),
            'hgrn_norm': f32(hgrn_norm[l]),
            'rwkv_mu': f32(rwkv_mu[l]), 'rwkv_w0': f32(rwkv_w0[l]), 'rwkv_w_up': f32(rwkv_w_up[l]),
            'rwkv_a0': f32(rwkv_a0[l]), 'rwkv_a_up': f32(rwkv_a_up[l]), 'rwkv_k_k': f32(rwkv_k_k[l]),
            'rwkv_k_a': f32(rwkv_k_a[l]), 'rwkv_r_k': f32(rwkv_r_k[l]), 'rwkv_gn_g': f32(rwkv_gn_g[l]),
            'rwkv_gn_b': f32(rwkv_gn_b[l]),
            'w_proj_a': w_proj_a[l], 'w_proj_b': w_proj_b[l], 'w_proj_c': w_proj_c[l], 'w_out': w_out[l],
        }
        x_p, st_p = layer(x_p, p, lb_all[l], init_p, seg_p)
        st_in = (state_mlstm_C[l], state_mlstm_n[l], state_mlstm_m[l], state_hgrn_S[l],
                 state_rwkv_S[l], cache_rwkv_shift[l])
        x_s, st_s = layer(x_s, p, lb_all[l], st_in, seg_s)
        outs_p.append(st_p)
        outs_s.append(st_s)

    mlstm_C_p, mlstm_n_p, mlstm_m_p, hgrn_S_p, rwkv_S_p, rwkv_shift_p = (
        jnp.stack([o[j] for o in outs_p]) for j in range(6))
    mlstm_C_s, mlstm_n_s, mlstm_m_s, hgrn_S_s, rwkv_S_s, rwkv_shift_s = (
        jnp.stack([o[j] for o in outs_s]) for j in range(6))
    y_prompt = x_p[:, N_META:]
    y_sample = x_s
    return (y_prompt, y_sample, mlstm_C_p, mlstm_n_p, mlstm_m_p, hgrn_S_p, rwkv_S_p, rwkv_shift_p,
            mlstm_C_s, mlstm_n_s, mlstm_m_s, hgrn_S_s, rwkv_S_s, rwkv_shift_s)
```

```cpp
#include <hip/hip_runtime.h>
#include <hip/hip_cooperative_groups.h>
#include <cstdio>
namespace cg = cooperative_groups;

#define LAS __attribute__((address_space(3)))
typedef unsigned short bf16_t;
typedef short bf16x8 __attribute__((ext_vector_type(8)));
typedef float f32x4 __attribute__((ext_vector_type(4)));
typedef float f32x2 __attribute__((ext_vector_type(2)));
typedef unsigned u32x4 __attribute__((ext_vector_type(4)));
typedef unsigned u32x2 __attribute__((ext_vector_type(2)));

constexpr int DM = 2048, MROWS = 18560, MPAD = 18688, NP_ROWS = 16512, TP = 2064;
constexpr int NIN = 15504, NINP = 15616;
constexpr int A_Q = 0, A_K = 1024, A_V = 2048, A_I = 3072, A_F = 3080, A_O = 3088, A_Z = 4112;
constexpr int B_Q = 5136, B_F = 5648, B_I = 6160, B_Z = 6672;
constexpr int C_BASE = 7184, C_COLS = 2176;
constexpr int CO_R = 0, CO_K = 512, CO_V = 1024, CO_WD = 1536, CO_AD = 1600, CO_Z = 1664;
constexpr int G_BASE = 9360;
constexpr int LDS_BYTES = 163840;
constexpr int NTHREADS = 512;

constexpr size_t O_YP = 0, O_YS = 33554432, O_CP = O_YS + 4194304, O_NP = O_CP + 2097152, O_MP = O_NP + 16384, O_HP = O_MP + 128,
                 O_RP = O_HP + 1048576, O_SHP = O_RP + 524288, O_CS = O_SHP + 34816, O_NS = O_CS + 8388608, O_MS = O_NS + 65536,
                 O_HS = O_MS + 512, O_RS = O_HS + 4194304, O_SHS = O_RS + 2097152, O_END = O_SHS + 139264;

constexpr size_t WS_WTIN = 0;
constexpr size_t WS_WTS = WS_WTIN + (size_t)NINP * 2048 * 2;
constexpr size_t WTS_LAYER = (size_t)2048 * 4096 * 2;
constexpr size_t WS_BUFA = WS_WTS + 2 * WTS_LAYER;
constexpr size_t BUF_BYTES = (size_t)MPAD * 2048 * 2;
constexpr size_t WS_BUFB = WS_BUFA + BUF_BYTES;
constexpr size_t WS_P = WS_BUFB + BUF_BYTES;
constexpr size_t WS_RX = WS_P + (size_t)MPAD * NINP * 2;
constexpr size_t RARR = (size_t)MPAD * 512 * 2;
constexpr size_t WS_XMETA = WS_RX + 4 * RARR;
constexpr size_t WS_END = WS_XMETA + (size_t)8 * 16 * 2048 * 4;

struct Params {
    const float* in[31];
    float* out;
    unsigned char* ws;
    int ph_lo, ph_hi, coop, pad;
};

__device__ __forceinline__ float bf2f(bf16_t x) { return __uint_as_float(((unsigned)x) << 16); }
__device__ __forceinline__ float bflo(unsigned w) { return __uint_as_float(w << 16); }
__device__ __forceinline__ float bfhi(unsigned w) { return __uint_as_float(w & 0xffff0000u); }
__device__ __forceinline__ bf16_t f2bf(float f) { unsigned u = __float_as_uint(f); u += 0x7FFFu + ((u >> 16) & 1u); return (bf16_t)(u >> 16); }
__device__ __forceinline__ unsigned pk2(float lo, float hi) { return (unsigned)f2bf(lo) | ((unsigned)f2bf(hi) << 16); }
__device__ __forceinline__ float sigmoidf_(float x) { return __builtin_amdgcn_rcpf(1.0f + __expf(-x)); }
__device__ __forceinline__ float logsigmoidf_(float x) { return fminf(x, 0.f) - __logf(1.0f + __expf(-fabsf(x))); }
__device__ __forceinline__ float wave_sum(float v) {
#pragma unroll
    for (int d = 32; d >= 1; d >>= 1) v += __shfl_xor(v, d);
    return v;
}
template <int CTRL> __device__ __forceinline__ float dppf(float v) { return __int_as_float(__builtin_amdgcn_update_dpp(0, __float_as_int(v), CTRL, 0xf, 0xf, true)); }
__device__ __forceinline__ float row16_sum(float v) {
    v += dppf<0xB1>(v); v += dppf<0x4E>(v); v += dppf<0x141>(v); v += dppf<0x140>(v); return v;
}

__device__ __forceinline__ int fresh_tid() { int t = threadIdx.x; asm volatile("" : "+v"(t)); return t; }
__device__ __forceinline__ const float* x0_row(const Params& p, int r) {
    if (r < NP_ROWS) { const int b = r / TP, t = r - b * TP; return t < 16 ? p.in[8] + (size_t)t * DM : p.in[0] + ((size_t)b * 2048 + (t - 16)) * DM; }
    return p.in[1] + (size_t)(r - NP_ROWS) * DM;
}
__device__ __forceinline__ float* x1_row(const Params& p, int r) {
    if (r < NP_ROWS) { const int b = r / TP, t = r - b * TP; return t < 16 ? (float*)(p.ws + WS_XMETA) + ((size_t)b * 16 + t) * DM : p.out + O_YP + ((size_t)b * 2048 + (t - 16)) * DM; }
    return p.out + O_YS + (size_t)(r - NP_ROWS) * DM;
}

namespace pg8 {
constexpr int BM = 256, BK = 64, HALF = 128, HTB = HALF * BK * 2, STAGE_BYTES = 8 * HTB, NXCD = 8, WGM = 8;
__device__ __forceinline__ int lds_byte(int r, int c) { const int st = (r >> 4) * 2 + (c >> 5), rr = r & 15, cc = c & 31, ob = rr * 64 + cc * 2; return st * 1024 + (ob ^ (((ob >> 9) & 1) << 5)); }
__device__ __forceinline__ void stage_rc(int b, int& R, int& C) { const int st = b / 1024, sb = b % 1024, swz = sb ^ (((sb >> 9) & 1) << 5); R = (st >> 1) * 16 + swz / 64; C = (st & 1) * 32 + (swz % 64) / 2; }
__device__ __forceinline__ int perm32(int rho) { const int n = rho >> 4, i = rho & 15; return 8 * (i >> 2) + 4 * n + (i & 3); }
struct Unit { int pm, pn; };
struct Gemm { const bf16_t* A; const bf16_t* Bt; int M, N, K; };
struct StaticOrder {
    int nM, nN, nwg, G, c;
    __device__ void init(int M, int N, int G_, int c_) { nM = M / BM; nN = N / BM; nwg = nM * nN; G = G_; c = c_; }
    __device__ bool next(int i, Unit& u) const {
        const long L = (long)i * G + c; if (L >= nwg) return false;
        int wgid = (int)L; { const int q = nwg / NXCD, r = nwg % NXCD, xcd = wgid % NXCD, off = wgid / NXCD; wgid = (xcd < r ? xcd * (q + 1) : r * (q + 1) + (xcd - r) * q) + off; }
        const int nig = WGM * nN, gid = wgid / nig, fm = gid * WGM, gsz = (nM - fm) < WGM ? (nM - fm) : WGM;
        u.pm = fm + ((wgid % nig) % gsz); u.pn = (wgid % nig) / gsz; return true;
    }
    __device__ __forceinline__ void a_ready(const Unit&) const {}
    __device__ __forceinline__ void done(const Unit&) const {}
};
__device__ __forceinline__ unsigned cvt_pk_bf16(float lo, float hi) { unsigned r; asm volatile("v_cvt_pk_bf16_f32 %0, %1, %2" : "=v"(r) : "v"(lo), "v"(hi)); return r; }

struct EpiStore {
    static constexpr bool PERM = true;
    bf16_t* O; int ldc;
    __device__ __forceinline__ void operator()(const f32x4 (&acc)[2][2][4][2], const Unit& u, int wr, int wc, int fr, int fq) const {
        const int row0 = u.pm * BM + wr * 64 + fr, col0 = u.pn * BM + wc * 32 + 8 * fq;
#pragma unroll
        for (int ai = 0; ai < 2; ++ai)
#pragma unroll
            for (int m = 0; m < 4; ++m) { bf16_t* rowp = O + (size_t)(row0 + ai * HALF + m * 16) * ldc + col0;
#pragma unroll
                for (int bj = 0; bj < 2; ++bj) { const f32x4 v0 = acc[ai][bj][m][0], v1 = acc[ai][bj][m][1];
                    u32x4 w; w.x = cvt_pk_bf16(v0[0], v0[1]); w.y = cvt_pk_bf16(v0[2], v0[3]); w.z = cvt_pk_bf16(v1[0], v1[1]); w.w = cvt_pk_bf16(v1[2], v1[3]);
                    *(u32x4*)(rowp + bj * HALF) = w; } }
    }
};
template <int MODE> struct EpiGate {
    static constexpr bool PERM = true;
    bf16_t* O; const bf16_t* G;
    __device__ __forceinline__ void operator()(const f32x4 (&acc)[2][2][4][2], const Unit& u, int wr, int wc, int fr, int fq) const {
        const int row0 = u.pm * BM + wr * 64 + fr, col0 = u.pn * BM + wc * 32 + 8 * fq;
#pragma unroll
        for (int ai = 0; ai < 2; ++ai)
#pragma unroll
            for (int m = 0; m < 4; ++m) { const size_t row = (size_t)(row0 + ai * HALF + m * 16);
#pragma unroll
                for (int bj = 0; bj < 2; ++bj) { const f32x4 v0 = acc[ai][bj][m][0], v1 = acc[ai][bj][m][1];
                    const u32x4 g = *(const u32x4*)(G + row * NINP + col0 + bj * HALF);
                    float r[8];
                    r[0] = v0[0] * sigmoidf_(bflo(g.x)); r[1] = v0[1] * sigmoidf_(bfhi(g.x)); r[2] = v0[2] * sigmoidf_(bflo(g.y)); r[3] = v0[3] * sigmoidf_(bfhi(g.y));
                    r[4] = v1[0] * sigmoidf_(bflo(g.z)); r[5] = v1[1] * sigmoidf_(bfhi(g.z)); r[6] = v1[2] * sigmoidf_(bflo(g.w)); r[7] = v1[3] * sigmoidf_(bfhi(g.w));
                    bf16_t* op = O + row * DM + col0 + bj * HALF;
                    if (MODE) { const u32x4 o = *(const u32x4*)op;
                        r[0] += bflo(o.x); r[1] += bfhi(o.x); r[2] += bflo(o.y); r[3] += bfhi(o.y); r[4] += bflo(o.z); r[5] += bfhi(o.z); r[6] += bflo(o.w); r[7] += bfhi(o.w); }
                    u32x4 w; w.x = cvt_pk_bf16(r[0], r[1]); w.y = cvt_pk_bf16(r[2], r[3]); w.z = cvt_pk_bf16(r[4], r[5]); w.w = cvt_pk_bf16(r[6], r[7]);
                    *(u32x4*)op = w; asm volatile("" ::: "memory"); } }
    }
};

template <class Epi, class Sched>
__device__ __forceinline__ void gemm_phase(LAS unsigned char* lds, const Gemm g, const Sched& S, const Epi& E) {
    const int tid = fresh_tid(), wid = __builtin_amdgcn_readfirstlane(tid >> 6), lane = tid & 63, wr = wid >> 2, wc = wid & 3, fr = lane & 15, fq = lane >> 4;
    const int K = g.K, nt = K / BK;
    unsigned voffA[2], voffB[2];
#pragma unroll
    for (int i = 0; i < 2; ++i) { int R, C; stage_rc(tid * 16 + i * 8192, R, C); const int Rb = Epi::PERM ? ((R & ~31) + perm32(R & 31)) : R;
        voffA[i] = (unsigned)(R * K + C) * 2u; voffB[i] = (unsigned)(Rb * K + C) * 2u; }
    const size_t kstep = (size_t)(BK * 2);
    const size_t hstep = (size_t)HALF * K * 2;
    const size_t tstep = 2 * hstep;
    const unsigned ldsw = (unsigned)wid * 1024u;
    const int aoff = lds_byte(wr * 64 + fr, fq * 8), boff = lds_byte(wc * 32 + fr, fq * 8);
#define PG8_SA(b, h) (((b) * 2 + (h)) * HTB)
#define PG8_SB(b, h) ((4 + (b) * 2 + (h)) * HTB)
#define PG8_STAGE(bufoff, gbase, voff) do { _Pragma("unroll") for (int _i = 0; _i < 2; ++_i) \
        __builtin_amdgcn_global_load_lds((const unsigned*)((const char*)(gbase) + (voff)[_i]), (LAS unsigned*)(lds + (bufoff) + ldsw + _i * 8192), 16, 0, 0); } while (0)
#define PG8_LDA(dst, b, h) do { _Pragma("unroll") for (int m = 0; m < 4; ++m) _Pragma("unroll") for (int k = 0; k < 2; ++k) dst[m][k] = *(const LAS bf16x8*)(lds + PG8_SA(b, h) + aoff + m * 2048 + k * 1024); } while (0)
#define PG8_LDB(dst, b, h) do { _Pragma("unroll") for (int n = 0; n < 2; ++n) _Pragma("unroll") for (int k = 0; k < 2; ++k) dst[n][k] = *(const LAS bf16x8*)(lds + PG8_SB(b, h) + boff + n * 2048 + k * 1024); } while (0)
#define PG8_MMA(ai, bj, At, Bt) do { __builtin_amdgcn_s_setprio(1); _Pragma("unroll") for (int m = 0; m < 4; ++m) _Pragma("unroll") for (int n = 0; n < 2; ++n) _Pragma("unroll") for (int k = 0; k < 2; ++k) \
        acc[ai][bj][m][n] = __builtin_amdgcn_mfma_f32_16x16x32_bf16(Bt[n][k], At[m][k], acc[ai][bj][m][n], 0, 0, 0); __builtin_amdgcn_s_setprio(0); } while (0)
#define PG8_WAIT_V(n) asm volatile("s_waitcnt vmcnt(" #n ")" ::: "memory")
#define PG8_WAIT_L(n) asm volatile("s_waitcnt lgkmcnt(" #n ")" ::: "memory")
#define PG8_BAR __builtin_amdgcn_s_barrier()
#define PG8_SCHED __builtin_amdgcn_sched_barrier(0)
    Unit cur, nxt; int ui = 0;
    if (!S.next(0, cur)) return;
    f32x4 acc[2][2][4][2];
#pragma unroll
    for (int a = 0; a < 2; ++a)
#pragma unroll
        for (int b = 0; b < 2; ++b)
#pragma unroll
            for (int m = 0; m < 4; ++m)
#pragma unroll
                for (int n = 0; n < 2; ++n) acc[a][b][m][n] = (f32x4){0.f, 0.f, 0.f, 0.f};
    bf16x8 At[4][2], B0[2][2], B1[2][2];
    const char* cA = (const char*)g.A + (size_t)cur.pm * tstep; const char* cB = (const char*)g.Bt + (size_t)cur.pn * tstep;
    S.a_ready(cur);
    PG8_STAGE(PG8_SB(0, 0), cB, voffB); PG8_STAGE(PG8_SA(0, 0), cA, voffA); PG8_STAGE(PG8_SB(0, 1), cB + hstep, voffB); PG8_STAGE(PG8_SA(0, 1), cA + hstep, voffA);
    if (wr == 1) PG8_BAR;
    PG8_WAIT_V(4); PG8_BAR;
    PG8_STAGE(PG8_SB(1, 0), cB + kstep, voffB); PG8_STAGE(PG8_SA(1, 0), cA + kstep, voffA); PG8_STAGE(PG8_SB(1, 1), cB + hstep + kstep, voffB);
    PG8_WAIT_V(6); PG8_BAR;
    for (;;) {
        const bool has_next = S.next(ui + 1, nxt);
        const char* nA = has_next ? (const char*)g.A + (size_t)nxt.pm * tstep : cA; const char* nB = has_next ? (const char*)g.Bt + (size_t)nxt.pn * tstep : cB;
        for (int t = 0; t < nt; t += 2) {
            const bool last = (t == nt - 2);
            const char* a1 = cA + (size_t)(t + 1) * kstep;
            const char* a2 = last ? nA : cA + (size_t)(t + 2) * kstep; const char* b2 = last ? nB : cB + (size_t)(t + 2) * kstep;
            const char* a3 = a2 + kstep; const char* b3 = b2 + kstep;
            if (last && has_next) S.a_ready(nxt);
            PG8_LDB(B0, 0, 0); PG8_SCHED; PG8_LDA(At, 0, 0); PG8_STAGE(PG8_SA(1, 1), a1 + hstep, voffA);
            PG8_WAIT_L(8); PG8_BAR; PG8_WAIT_L(0); PG8_MMA(0, 0, At, B0); PG8_BAR; PG8_SCHED;
            PG8_LDB(B1, 0, 1); PG8_STAGE(PG8_SB(0, 0), b2, voffB);
            PG8_BAR; PG8_WAIT_L(0); PG8_MMA(0, 1, At, B1); PG8_BAR;
            PG8_LDA(At, 0, 1); PG8_STAGE(PG8_SA(0, 0), a2, voffA);
            PG8_BAR; PG8_WAIT_L(0); PG8_MMA(1, 0, At, B0); PG8_BAR; PG8_SCHED;
            PG8_STAGE(PG8_SB(0, 1), b2 + hstep, voffB);
            PG8_WAIT_V(6); PG8_BAR; PG8_MMA(1, 1, At, B1); PG8_BAR;
            PG8_LDB(B0, 1, 0); PG8_SCHED; PG8_LDA(At, 1, 0); PG8_STAGE(PG8_SA(0, 1), a2 + hstep, voffA);
            PG8_WAIT_L(8); PG8_BAR; PG8_WAIT_L(0); PG8_MMA(0, 0, At, B0); PG8_BAR; PG8_SCHED;
            PG8_LDB(B1, 1, 1); PG8_STAGE(PG8_SB(1, 0), b3, voffB);
            PG8_BAR; PG8_WAIT_L(0); PG8_MMA(0, 1, At, B1); PG8_BAR;
            PG8_LDA(At, 1, 1); PG8_STAGE(PG8_SA(1, 0), a3, voffA);
            PG8_BAR; PG8_WAIT_L(0); PG8_MMA(1, 0, At, B0); PG8_BAR; PG8_SCHED;
            PG8_STAGE(PG8_SB(1, 1), b3 + hstep, voffB);
            PG8_WAIT_V(6); PG8_BAR; PG8_MMA(1, 1, At, B1); PG8_BAR;
        }
        E(acc, cur, wr, wc, fr, fq); S.done(cur);
        if (!has_next) break;
#pragma unroll
        for (int a = 0; a < 2; ++a)
#pragma unroll
            for (int b = 0; b < 2; ++b)
#pragma unroll
                for (int m = 0; m < 4; ++m)
#pragma unroll
                    for (int n = 0; n < 2; ++n) acc[a][b][m][n] = (f32x4){0.f, 0.f, 0.f, 0.f};
        cur = nxt; cA = nA; cB = nB; ++ui;
    }
    PG8_WAIT_V(0);
    if (wr == 0) PG8_BAR;
    PG8_BAR;
#undef PG8_SA
#undef PG8_SB
#undef PG8_STAGE
#undef PG8_LDA
#undef PG8_LDB
#undef PG8_MMA
#undef PG8_WAIT_V
#undef PG8_WAIT_L
#undef PG8_BAR
#undef PG8_SCHED
}
}

__device__ void convert_T(const float* __restrict__ W, int K, int N, int Npad, bf16_t* __restrict__ Wt, LAS float* tile, int t0, int tstride) {
    const int tid = fresh_tid(), tk = K / 64, tn = Npad / 64;
    for (int t = t0; t < tk * tn; t += tstride) {
        const int k0 = (t % tk) * 64, n0 = (t / tk) * 64;
#pragma unroll
        for (int i = 0; i < 2; ++i) { const int k = (tid >> 4) + 32 * i, n = (tid & 15) * 4;
            f32x4 v = (f32x4){0.f, 0.f, 0.f, 0.f};
            if (n0 + n < N) v = *(const f32x4*)(W + (size_t)(k0 + k) * N + n0 + n);
            tile[k * 65 + n] = v[0]; tile[k * 65 + n + 1] = v[1]; tile[k * 65 + n + 2] = v[2]; tile[k * 65 + n + 3] = v[3]; }
        __syncthreads();
        { const int n = tid >> 3, k8 = (tid & 7) * 8; u32x4 w;
          w.x = pk2(tile[(k8 + 0) * 65 + n], tile[(k8 + 1) * 65 + n]); w.y = pk2(tile[(k8 + 2) * 65 + n], tile[(k8 + 3) * 65 + n]);
          w.z = pk2(tile[(k8 + 4) * 65 + n], tile[(k8 + 5) * 65 + n]); w.w = pk2(tile[(k8 + 6) * 65 + n], tile[(k8 + 7) * 65 + n]);
          *(u32x4*)(Wt + (size_t)(n0 + n) * K + k0 + k8) = w; }
        __syncthreads();
    }
}

__device__ void prenorm0(const Params& p, int bid, int nb) {
    const int tid_ = fresh_tid(); const int lane = tid_ & 63, wid = tid_ >> 6;
    bf16_t* H = (bf16_t*)(p.ws + WS_BUFA);
    const float* g = p.in[9];
    for (int r = bid * 8 + wid; r < MROWS; r += nb * 8) {
        const float* x = x0_row(p, r);
        f32x4 v[8]; float ss = 0.f;
#pragma unroll
        for (int i = 0; i < 8; ++i) { v[i] = *(const f32x4*)(x + i * 256 + lane * 4); ss += v[i][0] * v[i][0] + v[i][1] * v[i][1] + v[i][2] * v[i][2] + v[i][3] * v[i][3]; }
        ss = wave_sum(ss);
        const float rs = rsqrtf(ss * (1.0f / DM) + 1e-6f);
#pragma unroll
        for (int i = 0; i < 8; ++i) { const f32x4 gg = *(const f32x4*)(g + i * 256 + lane * 4);
            u32x2 w; w.x = pk2(v[i][0] * rs * gg[0], v[i][1] * rs * gg[1]); w.y = pk2(v[i][2] * rs * gg[2], v[i][3] * rs * gg[3]);
            *(u32x2*)(H + (size_t)r * DM + i * 256 + lane * 4) = w; }
    }
}
__device__ void postnorm(const Params& p, int layer, int bid, int nb) {
    const int tid_ = fresh_tid(); const int lane = tid_ & 63, wid = tid_ >> 6;
    const bf16_t* Y = (const bf16_t*)(p.ws + WS_BUFB);
    bf16_t* H = (bf16_t*)(p.ws + WS_BUFA);
    const float* gpost = p.in[10] + layer * DM;
    const float* gpre = p.in[9] + DM;
    for (int r = bid * 8 + wid; r < MROWS; r += nb * 8) {
        const float* x = layer == 0 ? x0_row(p, r) : x1_row(p, r);
        float* xo = x1_row(p, r);
        float yv[32]; float ss = 0.f;
#pragma unroll
        for (int i = 0; i < 4; ++i) { const u32x4 w = *(const u32x4*)(Y + (size_t)r * DM + i * 512 + lane * 8);
            yv[i * 8 + 0] = bflo(w.x); yv[i * 8 + 1] = bfhi(w.x); yv[i * 8 + 2] = bflo(w.y); yv[i * 8 + 3] = bfhi(w.y);
            yv[i * 8 + 4] = bflo(w.z); yv[i * 8 + 5] = bfhi(w.z); yv[i * 8 + 6] = bflo(w.w); yv[i * 8 + 7] = bfhi(w.w); }
#pragma unroll
        for (int i = 0; i < 32; ++i) ss += yv[i] * yv[i];
        ss = wave_sum(ss);
        const float rs = rsqrtf(ss * (1.0f / DM) + 1e-6f);
        float s2 = 0.f;
#pragma unroll
        for (int i = 0; i < 4; ++i)
#pragma unroll
            for (int h = 0; h < 2; ++h) { const int c = i * 512 + lane * 8 + h * 4;
                const f32x4 xv = *(const f32x4*)(x + c); const f32x4 gg = *(const f32x4*)(gpost + c);
                f32x4 o;
#pragma unroll
                for (int j = 0; j < 4; ++j) { o[j] = xv[j] + yv[i * 8 + h * 4 + j] * rs * gg[j]; s2 += o[j] * o[j]; yv[i * 8 + h * 4 + j] = o[j]; }
                *(f32x4*)(xo + c) = o; }
        if (layer == 0) {
            s2 = wave_sum(s2);
            const float r2 = rsqrtf(s2 * (1.0f / DM) + 1e-6f);
#pragma unroll
            for (int i = 0; i < 4; ++i) { const int c = i * 512 + lane * 8;
                const f32x4 g0 = *(const f32x4*)(gpre + c), g1 = *(const f32x4*)(gpre + c + 4);
                u32x4 w; w.x = pk2(yv[i * 8 + 0] * r2 * g0[0], yv[i * 8 + 1] * r2 * g0[1]); w.y = pk2(yv[i * 8 + 2] * r2 * g0[2], yv[i * 8 + 3] * r2 * g0[3]);
                w.z = pk2(yv[i * 8 + 4] * r2 * g1[0], yv[i * 8 + 5] * r2 * g1[1]); w.w = pk2(yv[i * 8 + 6] * r2 * g1[2], yv[i * 8 + 7] * r2 * g1[3]);
                *(u32x4*)(H + (size_t)r * DM + c) = w; }
        }
    }
}

__device__ __forceinline__ bf16_t* rarr(const Params& p, int i) { return (bf16_t*)(i < 4 ? p.ws + WS_BUFA + (size_t)i * RARR : p.ws + WS_RX + (size_t)(i - 4) * RARR); }
__device__ void rwkv_prep(const Params& p, int layer, LAS unsigned char* lds, int bid, int nb) {
    const int tid = fresh_tid();
    LAS bf16_t* PC = (LAS bf16_t*)lds;
    LAS float* XW = (LAS float*)(lds + 17 * C_COLS * 2);
    LAS float* XA = XW + 16 * 64;
    const bf16_t* P = (const bf16_t*)(p.ws + WS_P);
    const float* mu = p.in[17] + layer * C_COLS;
    const float* w0 = p.in[18] + layer * 512; const float* wup = p.in[19] + (size_t)layer * 64 * 512;
    const float* a0 = p.in[20] + layer * 512; const float* aup = p.in[21] + (size_t)layer * 64 * 512;
    const float kkc = p.in[22][layer * 512 + tid], kac = p.in[23][layer * 512 + tid], rkc = p.in[24][layer * 512 + tid];
    bf16_t* oR = rarr(p, 0); bf16_t* oU = rarr(p, 1); bf16_t* oK = rarr(p, 2); bf16_t* oV = rarr(p, 3);
    bf16_t* oKK = rarr(p, 4); bf16_t* oKA = rarr(p, 5); bf16_t* oZS = rarr(p, 6); bf16_t* oBV = rarr(p, 7);
    for (int tile = bid; tile < MROWS / 16; tile += nb) {
        const int r0 = tile * 16;
        int seq_t0, seq_T, sb; bool sample;
        if (r0 < NP_ROWS) { sb = r0 / TP; seq_t0 = r0 - sb * TP; seq_T = TP; sample = false; } else { sb = (r0 - NP_ROWS) / 64; seq_t0 = (r0 - NP_ROWS) - sb * 64; seq_T = 64; sample = true; }
        for (int i = tid; i < 17 * (C_COLS / 8); i += NTHREADS) { const int rr = i / (C_COLS / 8), cc = (i - rr * (C_COLS / 8)) * 8;
            u32x4 v = (u32x4){0u, 0u, 0u, 0u};
            if (rr > 0 || seq_t0 > 0) v = *(const u32x4*)(P + (size_t)(r0 - 1 + rr) * NINP + C_BASE + cc);
            else if (sample) { const float* sh = p.in[7] + ((size_t)layer * 32 + sb) * C_COLS + cc;
                v.x = pk2(sh[0], sh[1]); v.y = pk2(sh[2], sh[3]); v.z = pk2(sh[4], sh[5]); v.w = pk2(sh[6], sh[7]); }
            *(LAS u32x4*)(PC + rr * C_COLS + cc) = v; }
        __syncthreads();
        for (int i = tid; i < 16 * 128; i += NTHREADS) { const int tok = i >> 7, j = i & 127, col = CO_WD + j;
            const float pc = bf2f(PC[(tok + 1) * C_COLS + col]), pv = bf2f(PC[tok * C_COLS + col]);
            const float xs = pc + mu[col] * (pv - pc);
            if (j < 64) { const float e = __expf(2.f * xs); XW[tok * 64 + j] = 1.f - 2.f * __builtin_amdgcn_rcpf(e + 1.f); } else XA[tok * 64 + (j - 64)] = xs; }
        if (seq_t0 + 16 == seq_T) { float* so = p.out + (sample ? O_SHS + ((size_t)layer * 32 + sb) * C_COLS : O_SHP + ((size_t)layer * 8 + sb) * C_COLS);
            for (int i = tid; i < C_COLS; i += NTHREADS) so[i] = bf2f(PC[16 * C_COLS + i]); }
        __syncthreads();
        float aw[16], aa[16];
#pragma unroll
        for (int t = 0; t < 16; ++t) { aw[t] = 0.f; aa[t] = 0.f; }
        for (int j = 0; j < 64; j += 4) {
            float wu[4], au[4];
#pragma unroll
            for (int q = 0; q < 4; ++q) { wu[q] = wup[(size_t)(j + q) * 512 + tid]; au[q] = aup[(size_t)(j + q) * 512 + tid]; }
#pragma unroll
            for (int t = 0; t < 16; ++t) { const f32x4 xw = *(const LAS f32x4*)(XW + t * 64 + j), xa = *(const LAS f32x4*)(XA + t * 64 + j);
                aw[t] += xw[0] * wu[0] + xw[1] * wu[1] + xw[2] * wu[2] + xw[3] * wu[3];
                aa[t] += xa[0] * au[0] + xa[1] * au[1] + xa[2] * au[2] + xa[3] * au[3]; }
        }
        const float w0c = w0[tid], a0c = a0[tid];
        const float mur = mu[CO_R + tid], muk = mu[CO_K + tid], muv = mu[CO_V + tid], muz = mu[CO_Z + tid];
#pragma unroll 4
        for (int t = 0; t < 16; ++t) {
            const LAS bf16_t* pc = PC + (t + 1) * C_COLS; const LAS bf16_t* pp = PC + t * C_COLS;
            float c_, q_;
            c_ = bf2f(pc[CO_R + tid]); q_ = bf2f(pp[CO_R + tid]); const float r = c_ + mur * (q_ - c_);
            c_ = bf2f(pc[CO_K + tid]); q_ = bf2f(pp[CO_K + tid]); const float k = c_ + muk * (q_ - c_);
            c_ = bf2f(pc[CO_V + tid]); q_ = bf2f(pp[CO_V + tid]); const float v = c_ + muv * (q_ - c_);
            c_ = bf2f(pc[CO_Z + tid]); q_ = bf2f(pp[CO_Z + tid]); const float z = c_ + muz * (q_ - c_);
            const float e = sigmoidf_(w0c + aw[t]) * 0.60653066f;
            const float u = 1.f - __expf(-e);
            const float a = sigmoidf_(a0c + aa[t]);
            float kk = k * kkc;
            const float nrm = sqrtf(wave_sum(kk * kk));
            kk = kk / fmaxf(nrm, 1e-12f);
            const float kt = k * (1.f + (a - 1.f) * kac);
            const float rk = wave_sum(r * kt * rkc);
            const float zs = z * sigmoidf_(z);
            const size_t o = (size_t)(r0 + t) * 512 + tid;
            oR[o] = f2bf(r); oU[o] = f2bf(u); oK[o] = f2bf(kt); oV[o] = f2bf(v); oKK[o] = f2bf(kk); oKA[o] = f2bf(kk * a); oZS[o] = f2bf(zs); oBV[o] = f2bf(rk * v * zs);
        }
        __syncthreads();
    }
}

__device__ void rwkv_scan(const Params& p, int layer, int bseq, int head, bool sample, LAS unsigned char* lds) {
    const int tid = fresh_tid(), rp = tid >> 4, part = tid & 15;
    LAS float* LR = (LAS float*)lds;
    LAS float* LU = LR + 4096; LAS float* LK = LU + 4096; LAS float* LKK = LK + 4096; LAS float* LKA = LKK + 4096; LAS float* LV = LKA + 4096; LAS float* LY = LV + 4096;
    const int row_base = sample ? NP_ROWS + bseq * 64 : bseq * TP;
    const int T = sample ? 64 : TP;
    const int nch = (T + 63) / 64;
    f32x4 s0 = (f32x4){0.f, 0.f, 0.f, 0.f}, s1 = s0;
    if (sample) { const float* S = p.in[6] + ((((size_t)layer * 32 + bseq) * 8 + head) * 64) * 64;
        s0 = *(const f32x4*)(S + (unsigned)((2 * rp) * 64 + part * 4)); s1 = *(const f32x4*)(S + (unsigned)((2 * rp + 1) * 64 + part * 4)); }
    const int st = tid >> 3, sp = (tid & 7) * 8;
    const unsigned poff = (unsigned)(st * 512 + sp);
    u32x4 pf[8];
#define RW_PREFETCH(c) do { const int _t = (c) * 64 + st; if (_t < T) { const size_t _o = (size_t)(row_base + (c) * 64) * 512 + head * 64; \
        _Pragma("unroll") for (int _i = 0; _i < 8; ++_i) pf[_i] = *(const u32x4*)(rarr(p, _i) + _o + poff); } \
        else { _Pragma("unroll") for (int _i = 0; _i < 8; ++_i) pf[_i] = (u32x4){0u, 0u, 0u, 0u}; } } while (0)
    RW_PREFETCH(0);
    const float* gng = p.in[25] + layer * 512 + head * 64; const float* gnb = p.in[26] + layer * 512 + head * 64;
    bf16_t* YC = (bf16_t*)(p.ws + WS_BUFB) + (size_t)MPAD * 1536;
    for (int c = 0; c < nch; ++c) {
        const int L = (T - c * 64) < 64 ? (T - c * 64) : 64;
        {
            LAS float* dst[6] = {LR, LU, LK, LV, LKK, LKA};
#pragma unroll
            for (int i = 0; i < 6; ++i) { const u32x4 w = pf[i]; LAS float* d = dst[i] + st * 64 + sp;
                *(LAS f32x4*)d = (f32x4){bflo(w.x), bfhi(w.x), bflo(w.y), bfhi(w.y)}; *(LAS f32x4*)(d + 4) = (f32x4){bflo(w.z), bfhi(w.z), bflo(w.w), bfhi(w.w)}; }
        }
        const u32x4 zs = pf[6], bv = pf[7];
        __syncthreads();
        if (c + 1 < nch) RW_PREFETCH(c + 1);
        for (int t = 0; t < L; ++t) {
            const f32x4 kk = *(const LAS f32x4*)(LKK + t * 64 + part * 4);
            const f32x4 u = *(const LAS f32x4*)(LU + t * 64 + part * 4);
            const f32x4 ka = *(const LAS f32x4*)(LKA + t * 64 + part * 4);
            const f32x4 k = *(const LAS f32x4*)(LK + t * 64 + part * 4);
            const f32x4 r = *(const LAS f32x4*)(LR + t * 64 + part * 4);
            const f32x2 v = *(const LAS f32x2*)(LV + t * 64 + 2 * rp);
            float d0 = s0[0] * kk[0] + s0[1] * kk[1] + s0[2] * kk[2] + s0[3] * kk[3];
            float d1 = s1[0] * kk[0] + s1[1] * kk[1] + s1[2] * kk[2] + s1[3] * kk[3];
            d0 = -row16_sum(d0); d1 = -row16_sum(d1);
#pragma unroll
            for (int j = 0; j < 4; ++j) { s0[j] = (s0[j] - s0[j] * u[j]) + d0 * ka[j] + v[0] * k[j]; s1[j] = (s1[j] - s1[j] * u[j]) + d1 * ka[j] + v[1] * k[j]; }
            float y0 = s0[0] * r[0] + s0[1] * r[1] + s0[2] * r[2] + s0[3] * r[3];
            float y1 = s1[0] * r[0] + s1[1] * r[1] + s1[2] * r[2] + s1[3] * r[3];
            y0 = row16_sum(y0); y1 = row16_sum(y1);
            if (part == 0) *(LAS f32x2*)(LY + t * 64 + 2 * rp) = (f32x2){y0, y1};
        }
        __syncthreads();
        {
            const f32x4 ya = *(const LAS f32x4*)(LY + st * 64 + sp), yb = *(const LAS f32x4*)(LY + st * 64 + sp + 4);
            float y[8] = {ya[0], ya[1], ya[2], ya[3], yb[0], yb[1], yb[2], yb[3]};
            float sm = 0.f;
#pragma unroll
            for (int j = 0; j < 8; ++j) sm += y[j];
            sm += __shfl_xor(sm, 1); sm += __shfl_xor(sm, 2); sm += __shfl_xor(sm, 4);
            const float mean = sm * (1.f / 64.f);
            float sv = 0.f;
#pragma unroll
            for (int j = 0; j < 8; ++j) { y[j] -= mean; sv += y[j] * y[j]; }
            sv += __shfl_xor(sv, 1); sv += __shfl_xor(sv, 2); sv += __shfl_xor(sv, 4);
            const float rstd = rsqrtf(sv * (1.f / 64.f) + 64e-5f);
            const f32x4 g0 = *(const f32x4*)(gng + (unsigned)sp), g1 = *(const f32x4*)(gng + 4 + (unsigned)sp), b0 = *(const f32x4*)(gnb + (unsigned)sp), b1 = *(const f32x4*)(gnb + 4 + (unsigned)sp);
            const float gg[8] = {g0[0], g0[1], g0[2], g0[3], g1[0], g1[1], g1[2], g1[3]}, bb[8] = {b0[0], b0[1], b0[2], b0[3], b1[0], b1[1], b1[2], b1[3]};
            const float zz[8] = {bflo(zs.x), bfhi(zs.x), bflo(zs.y), bfhi(zs.y), bflo(zs.z), bfhi(zs.z), bflo(zs.w), bfhi(zs.w)};
            const float vv[8] = {bflo(bv.x), bfhi(bv.x), bflo(bv.y), bfhi(bv.y), bflo(bv.z), bfhi(bv.z), bflo(bv.w), bfhi(bv.w)};
            float o[8];
#pragma unroll
            for (int j = 0; j < 8; ++j) o[j] = (y[j] * rstd * gg[j] + bb[j]) * zz[j] + vv[j];
            if (st < L) { u32x4 w; w.x = pk2(o[0], o[1]); w.y = pk2(o[2], o[3]); w.z = pk2(o[4], o[5]); w.w = pk2(o[6], o[7]);
                *(u32x4*)(YC + (size_t)(row_base + c * 64) * 512 + head * 64 + poff) = w; }
        }
        __syncthreads();
    }
#undef RW_PREFETCH
    { float* So = p.out + (sample ? O_RS + ((((size_t)layer * 32 + bseq) * 8 + head) * 64) * 64 : O_RP + ((((size_t)layer * 8 + bseq) * 8 + head) * 64) * 64);
      *(f32x4*)(So + (unsigned)((2 * rp) * 64 + part * 4)) = s0; *(f32x4*)(So + (unsigned)((2 * rp + 1) * 64 + part * 4)) = s1; }
}

constexpr int QS_LD = 136, VT_LD = 72, HO_LD = 132;
constexpr int L_QS = 0, L_KS = L_QS + 64 * QS_LD * 2, L_VT = L_KS + 64 * QS_LD * 2, L_KT = L_VT + 144 * VT_LD * 2, L_CB = L_KT + 128 * VT_LD * 2,
              L_SS = L_CB + 144 * QS_LD * 2, L_HO = L_SS + 64 * VT_LD * 2, L_GT = L_HO + 64 * HO_LD * 4, L_END = L_GT + 6144;
static_assert(L_END <= LDS_BYTES, "LDS overflow");
constexpr int G_B = 0, G_IG = 64, G_MT = 128, G_WI = 192, G_EMT = 256, G_WS = 320, G_DEN = 384, G_AMID = 448, G_AEND = 576, G_TOT = 704, G_LB = 1216, G_SC = 1344;

#define FRESH_IDS int T_ = threadIdx.x; asm volatile("" : "+v"(T_)); const int lane = T_ & 63; const int wid = __builtin_amdgcn_readfirstlane(T_ >> 6); \
    const int l15 = lane & 15, lq = lane >> 4, st = T_ >> 3, sp = (T_ & 7) * 16; (void)lane; (void)wid; (void)l15; (void)lq; (void)st; (void)sp;
template <int KIND>
__device__ void chunk_unit(const Params& p, int layer, int bseq, int head, bool sample, LAS unsigned char* lds) {
    constexpr int NVT = KIND == 0 ? 9 : 8;
    LAS bf16_t* QS = (LAS bf16_t*)(lds + L_QS); LAS bf16_t* KS = (LAS bf16_t*)(lds + L_KS); LAS bf16_t* VT = (LAS bf16_t*)(lds + L_VT);
    LAS bf16_t* KT = (LAS bf16_t*)(lds + L_KT); LAS bf16_t* CB = (LAS bf16_t*)(lds + L_CB); LAS bf16_t* SS = (LAS bf16_t*)(lds + L_SS);
    LAS float* HO = (LAS float*)(lds + L_HO); LAS float* GT = (LAS float*)(lds + L_GT);
    const bf16_t* P = (const bf16_t*)(p.ws + WS_P);
    const int cq = KIND == 0 ? A_Q + head * 128 : B_Q + head * 128;
    const int ck = KIND == 0 ? A_K + head * 128 : B_F + head * 128;
    const int cv = KIND == 0 ? A_V + head * 128 : B_I + head * 128;
    const int cz = KIND == 0 ? A_Z + head * 128 : B_Z + head * 128;
    const int co = A_O + head * 128;
    const int row_base = sample ? NP_ROWS + bseq * 64 : bseq * TP;
    const int nchunks = sample ? 1 : 33;
    const int NB = sample ? 32 : 8;

    f32x4 C[NVT];
#pragma unroll
    for (int vt = 0; vt < NVT; ++vt) C[vt] = (f32x4){0.f, 0.f, 0.f, 0.f};
    float m_run = 0.f;
    {
        FRESH_IDS
        if (sample) {
            if (KIND == 0) {
                const float* Cin = p.in[2] + ((((size_t)layer * 32 + bseq) * 8 + head) * 128) * 128;
#pragma unroll
                for (int vt = 0; vt < 8; ++vt)
#pragma unroll
                    for (int j = 0; j < 4; ++j) C[vt][j] = Cin[(unsigned)((vt * 16 + lq * 4 + j) * 128 + wid * 16 + l15)];
                if (lq == 0) C[NVT - 1][0] = (p.in[3] + (((size_t)layer * 32 + bseq) * 8 + head) * 128)[(unsigned)(wid * 16 + l15)];
                m_run = p.in[4][((size_t)layer * 32 + bseq) * 8 + head];
            } else {
                const float* Sin = p.in[5] + ((((size_t)layer * 32 + bseq) * 4 + head) * 128) * 128;
#pragma unroll
                for (int vt = 0; vt < 8; ++vt) C[vt] = *(const f32x4*)(Sin + (unsigned)((wid * 16 + l15) * 128 + vt * 16 + lq * 4));
            }
        }
        if (KIND == 0) { for (int i = T_; i < 16 * 64; i += NTHREADS) { const int rr = i >> 6, ss = i & 63; VT[(128 + rr) * VT_LD + ss] = rr == 0 ? (bf16_t)0x3F80 : (bf16_t)0; } }
        else if (T_ < 128) { float lb = 0.f; if (layer == 1) { const float l0 = p.in[15][head * 128 + T_], l1 = p.in[15][512 + head * 128 + T_]; lb = sigmoidf_(l1 - l0); } GT[G_LB + T_] = lb; }
    }
    const float b_i = KIND == 0 ? p.in[12][layer * 8 + head] : 0.f, b_f = KIND == 0 ? p.in[13][layer * 8 + head] : 0.f;

    u32x4 pq[2], pk[2], pv[2]; bf16_t pgi = 0, pgf = 0;
#define CU_PREFETCH(c) do { FRESH_IDS const int _t0 = sample ? 0 : ((c) == 0 ? 0 : 16 + 64 * ((c) - 1)); const int _L = (!sample && (c) == 0) ? 16 : 64; \
        const bf16_t* _r = P + (size_t)(row_base + _t0) * NINP; const unsigned toff = (unsigned)(st * NINP + sp); \
        if (st < _L) { \
            pq[0] = *(const u32x4*)(_r + cq + toff); pq[1] = *(const u32x4*)(_r + cq + 8 + toff); pk[0] = *(const u32x4*)(_r + ck + toff); pk[1] = *(const u32x4*)(_r + ck + 8 + toff); \
            pv[0] = *(const u32x4*)(_r + cv + toff); pv[1] = *(const u32x4*)(_r + cv + 8 + toff); } \
        else { pq[0] = pq[1] = pk[0] = pk[1] = pv[0] = pv[1] = (u32x4){0u, 0u, 0u, 0u}; } \
        if (KIND == 0 && T_ < 64) { if (T_ < _L) { const unsigned goff = (unsigned)(T_ * NINP); pgi = (_r + A_I + head)[goff]; pgf = (_r + A_F + head)[goff]; } } } while (0)
    CU_PREFETCH(0);
    if (KIND == 1) __syncthreads();

    for (int c = 0; c < nchunks; ++c) {
        const int t0 = sample ? 0 : (c == 0 ? 0 : 16 + 64 * (c - 1));
        const int L = (!sample && c == 0) ? 16 : 64;
        float qf[16], kf[16];
        {
            FRESH_IDS
            const unsigned qw[8] = {pq[0].x, pq[0].y, pq[0].z, pq[0].w, pq[1].x, pq[1].y, pq[1].z, pq[1].w};
            const unsigned kw[8] = {pk[0].x, pk[0].y, pk[0].z, pk[0].w, pk[1].x, pk[1].y, pk[1].z, pk[1].w};
            const unsigned vw[8] = {pv[0].x, pv[0].y, pv[0].z, pv[0].w, pv[1].x, pv[1].y, pv[1].z, pv[1].w};
            (void)qw;
            { LAS bf16_t* vtp = VT + sp * VT_LD + st;
#pragma unroll
              for (int j = 0; j < 8; ++j) { vtp[(2 * j) * VT_LD] = (bf16_t)(vw[j] & 0xffffu); vtp[(2 * j + 1) * VT_LD] = (bf16_t)(vw[j] >> 16); } }
            if (KIND == 0) {
                *(LAS u32x4*)(QS + st * QS_LD + sp) = pq[0]; *(LAS u32x4*)(QS + st * QS_LD + sp + 8) = pq[1];
                u32x4 k0, k1; const float sc = 0.08838834764831845f;
                k0.x = pk2(bflo(kw[0]) * sc, bfhi(kw[0]) * sc); k0.y = pk2(bflo(kw[1]) * sc, bfhi(kw[1]) * sc); k0.z = pk2(bflo(kw[2]) * sc, bfhi(kw[2]) * sc); k0.w = pk2(bflo(kw[3]) * sc, bfhi(kw[3]) * sc);
                k1.x = pk2(bflo(kw[4]) * sc, bfhi(kw[4]) * sc); k1.y = pk2(bflo(kw[5]) * sc, bfhi(kw[5]) * sc); k1.z = pk2(bflo(kw[6]) * sc, bfhi(kw[6]) * sc); k1.w = pk2(bflo(kw[7]) * sc, bfhi(kw[7]) * sc);
                *(LAS u32x4*)(KS + st * QS_LD + sp) = k0; *(LAS u32x4*)(KS + st * QS_LD + sp + 8) = k1;
                pk[0] = k0; pk[1] = k1;
                if (wid == 0) {
                    const float ig = lane < L ? bf2f(pgi) + b_i : -1e30f;
                    const float lf = lane < L ? logsigmoidf_(bf2f(pgf) + b_f) : 0.f;
                    float b = lf;
#pragma unroll
                    for (int d = 1; d < 64; d <<= 1) { const float y = __shfl_up(b, d); if (lane >= d) b += y; }
                    float pm = ig - b;
#pragma unroll
                    for (int d = 1; d < 64; d <<= 1) { const float y = __shfl_up(pm, d); if (lane >= d) pm = fmaxf(pm, y); }
                    const float b_end = __shfl(b, 63), pm_end = __shfl(pm, 63);
                    const float mt = b + fmaxf(m_run, pm);
                    const float m_new = b_end + fmaxf(m_run, pm_end);
                    GT[G_B + lane] = b; GT[G_IG + lane] = ig; GT[G_MT + lane] = mt; GT[G_WI + lane] = __expf(b + m_run - mt); GT[G_EMT + lane] = __expf(-mt);
                    GT[G_WS + lane] = __expf(b_end - b + ig - m_new);
                    if (lane == 0) { GT[G_SC + 0] = __expf(b_end + m_run - m_new); GT[G_SC + 1] = m_new; }
                }
                { LAS bf16_t* cbp = CB + (lq * 4) * QS_LD + wid * 16 + l15;
#pragma unroll
                  for (int vt = 0; vt < NVT; ++vt)
#pragma unroll
                    for (int j = 0; j < 4; ++j) cbp[(vt * 16 + j) * QS_LD] = f2bf(C[vt][j]); }
            } else {
#pragma unroll
                for (int j = 0; j < 8; ++j) {
#pragma unroll
                    for (int h = 0; h < 2; ++h) { const int e = 2 * j + h;
                        const float fp = h ? bfhi(kw[j]) : bflo(kw[j]); qf[e] = h ? bfhi(qw[j]) : bflo(qw[j]);
                        const float lb = GT[G_LB + sp + e]; const float sg = sigmoidf_(fp);
                        float lf = __logf(lb + (1.f - lb) * sg); float kk = (1.f - lb) * (1.f - sg);
                        if (st >= L) { lf = 0.f; kk = 0.f; }
                        kf[e] = kk; HO[st * HO_LD + sp + e] = lf; }
                }
            }
        }
        __syncthreads();
        float w_old = 1.f, m_new = 0.f;
        if (KIND == 0) {
            FRESH_IDS
            w_old = GT[G_SC + 0]; m_new = GT[G_SC + 1];
            const float wsv = GT[G_WS + st];
            const unsigned kw[8] = {pk[0].x, pk[0].y, pk[0].z, pk[0].w, pk[1].x, pk[1].y, pk[1].z, pk[1].w};
            LAS bf16_t* ktp = KT + sp * VT_LD + st;
#pragma unroll
            for (int j = 0; j < 8; ++j) { ktp[(2 * j) * VT_LD] = f2bf(bflo(kw[j]) * wsv); ktp[(2 * j + 1) * VT_LD] = f2bf(bfhi(kw[j]) * wsv); }
        } else {
            { FRESH_IDS const int k = T_ & 127, tg = T_ >> 7; float run = 0.f; LAS float* hp = HO + (tg * 16) * HO_LD + k;
#pragma unroll
              for (int i = 0; i < 16; ++i) { run += hp[i * HO_LD]; hp[i * HO_LD] = run; }
              GT[G_TOT + tg * 128 + k] = run; }
            __syncthreads();
            { FRESH_IDS const int k = T_ & 127, tg = T_ >> 7; float off = 0.f; LAS float* hp = HO + (tg * 16) * HO_LD + k;
              for (int g = 0; g < tg; ++g) off += GT[G_TOT + g * 128 + k];
              if (tg > 0) {
#pragma unroll
                  for (int i = 0; i < 16; ++i) hp[i * HO_LD] += off; }
              if (tg == 1) GT[G_AMID + k] = hp[15 * HO_LD];
              if (tg == 3) GT[G_AEND + k] = hp[15 * HO_LD]; }
            __syncthreads();
            {
                FRESH_IDS
                unsigned qa[8], kb[8];
                LAS bf16_t* ktp = KT + sp * VT_LD + st; LAS float* hp = HO + st * HO_LD + sp; LAS float* gm = GT + G_AMID + sp; LAS float* ge = GT + G_AEND + sp;
#pragma unroll
                for (int j = 0; j < 8; ++j) { float qv[2], kv[2];
#pragma unroll
                    for (int h = 0; h < 2; ++h) { const int e = 2 * j + h; const float a = hp[e], am = gm[e], ae = ge[e];
                        qv[h] = qf[e] * __expf(a - am); kv[h] = kf[e] * __expf(am - a);
                        ktp[e * VT_LD] = f2bf(kf[e] * __expf(ae - a)); }
                    qa[j] = pk2(qv[0], qv[1]); kb[j] = pk2(kv[0], kv[1]); }
                *(LAS u32x4*)(QS + st * QS_LD + sp) = (u32x4){qa[0], qa[1], qa[2], qa[3]}; *(LAS u32x4*)(QS + st * QS_LD + sp + 8) = (u32x4){qa[4], qa[5], qa[6], qa[7]};
                *(LAS u32x4*)(KS + st * QS_LD + sp) = (u32x4){kb[0], kb[1], kb[2], kb[3]}; *(LAS u32x4*)(KS + st * QS_LD + sp + 8) = (u32x4){kb[4], kb[5], kb[6], kb[7]};
                const float eam = __expf(GT[G_AMID + wid * 16 + l15]);
                LAS bf16_t* cbp = CB + (lq * 4) * QS_LD + wid * 16 + l15;
#pragma unroll
                for (int vt = 0; vt < NVT; ++vt)
#pragma unroll
                    for (int j = 0; j < 4; ++j) cbp[(vt * 16 + j) * QS_LD] = f2bf(C[vt][j] * eam);
            }
            __syncthreads();
        }
        if (c + 1 < nchunks) CU_PREFETCH(c + 1);
        {
            FRESH_IDS
            const int ti = wid >> 1;
#pragma unroll
            for (int sjj = 0; sjj < 2; ++sjj) {
                const int sj = 2 * (wid & 1) + sjj;
                f32x4 a = (f32x4){0.f, 0.f, 0.f, 0.f};
                const LAS bf16_t* qp = QS + (ti * 16 + l15) * QS_LD + lq * 8; const LAS bf16_t* kp = KS + (sj * 16 + l15) * QS_LD + lq * 8;
#pragma unroll
                for (int kk = 0; kk < 4; ++kk) { const bf16x8 fa = *(const LAS bf16x8*)(qp + kk * 32); const bf16x8 fb = *(const LAS bf16x8*)(kp + kk * 32);
                    a = __builtin_amdgcn_mfma_f32_16x16x32_bf16(fa, fb, a, 0, 0, 0); }
                const int s = sj * 16 + l15;
                const float cs_ = KIND == 0 ? GT[G_IG + s] - GT[G_B + s] : 0.f;
                LAS bf16_t* ssp = SS + (ti * 16 + lq * 4) * VT_LD + s;
#pragma unroll
                for (int j = 0; j < 4; ++j) { const int t = ti * 16 + lq * 4 + j; float val;
                    if (KIND == 0) { const float arg = s <= t ? (GT[G_B + t] - GT[G_MT + t]) + cs_ : -1e30f; val = a[j] * __expf(arg); } else val = s <= t ? a[j] : 0.f;
                    ssp[j * VT_LD] = f2bf(val); }
            }
        }
        f32x4 hacc[5];
#pragma unroll
        for (int i = 0; i < 5; ++i) hacc[i] = (f32x4){0.f, 0.f, 0.f, 0.f};
        {
            FRESH_IDS
            const int hti = wid & 3, hv0 = (wid >> 2) * 4;
            const LAS bf16_t* qp = QS + (hti * 16 + l15) * QS_LD + lq * 8; const LAS bf16_t* cp = CB + (hv0 * 16 + l15) * QS_LD + lq * 8; const LAS bf16_t* cn = CB + (128 + l15) * QS_LD + lq * 8;
#pragma unroll
            for (int kk = 0; kk < 4; ++kk) {
                const bf16x8 fa = *(const LAS bf16x8*)(qp + kk * 32);
#pragma unroll
                for (int i = 0; i < 4; ++i) { const bf16x8 fb = *(const LAS bf16x8*)(cp + i * 16 * QS_LD + kk * 32); hacc[i] = __builtin_amdgcn_mfma_f32_16x16x32_bf16(fa, fb, hacc[i], 0, 0, 0); }
                if (KIND == 0 && wid < 4) { const bf16x8 fb = *(const LAS bf16x8*)(cn + kk * 32); hacc[4] = __builtin_amdgcn_mfma_f32_16x16x32_bf16(fa, fb, hacc[4], 0, 0, 0); }
                __builtin_amdgcn_sched_barrier(0);
            }
            if (KIND == 0) {
#pragma unroll
                for (int j = 0; j < 4; ++j) { const float wi = GT[G_WI + hti * 16 + lq * 4 + j];
#pragma unroll
                    for (int i = 0; i < 5; ++i) hacc[i][j] *= wi; }
            }
        }
        __syncthreads();
        u32x4 pz[2], po[2];
        {
            FRESH_IDS
            const int hti = wid & 3, hv0 = (wid >> 2) * 4;
            const LAS bf16_t* sp_ = SS + (hti * 16 + l15) * VT_LD + lq * 8; const LAS bf16_t* vp = VT + (hv0 * 16 + l15) * VT_LD + lq * 8; const LAS bf16_t* vn = VT + (128 + l15) * VT_LD + lq * 8;
#pragma unroll
            for (int kk = 0; kk < 2; ++kk) {
                const bf16x8 fa = *(const LAS bf16x8*)(sp_ + kk * 32);
#pragma unroll
                for (int i = 0; i < 4; ++i) { const bf16x8 fb = *(const LAS bf16x8*)(vp + i * 16 * VT_LD + kk * 32); hacc[i] = __builtin_amdgcn_mfma_f32_16x16x32_bf16(fa, fb, hacc[i], 0, 0, 0); }
                if (KIND == 0 && wid < 4) { const bf16x8 fb = *(const LAS bf16x8*)(vn + kk * 32); hacc[4] = __builtin_amdgcn_mfma_f32_16x16x32_bf16(fa, fb, hacc[4], 0, 0, 0); }
                __builtin_amdgcn_sched_barrier(0);
            }
            { const bf16_t* r_ = P + (size_t)(row_base + t0) * NINP; const unsigned zo = st < L ? (unsigned)(st * NINP + sp) : (unsigned)sp;
              pz[0] = *(const u32x4*)(r_ + cz + zo); pz[1] = *(const u32x4*)(r_ + cz + 8 + zo);
              if (KIND == 0) { po[0] = *(const u32x4*)(r_ + co + zo); po[1] = *(const u32x4*)(r_ + co + 8 + zo); } }
            if (KIND == 0) {
                if (wid < 4 && l15 == 0) {
#pragma unroll
                    for (int j = 0; j < 4; ++j) GT[G_DEN + hti * 16 + lq * 4 + j] = hacc[4][j]; }
                __syncthreads();
                LAS float* hp = HO + (hti * 16 + lq * 4) * HO_LD + hv0 * 16 + l15;
#pragma unroll
                for (int j = 0; j < 4; ++j) { const int t = hti * 16 + lq * 4 + j; const float dn = __builtin_amdgcn_rcpf(fmaxf(fabsf(GT[G_DEN + t]), GT[G_EMT + t]));
#pragma unroll
                    for (int i = 0; i < 4; ++i) hp[j * HO_LD + i * 16] = hacc[i][j] * dn; }
            } else {
                LAS float* hp = HO + (hti * 16 + lq * 4) * HO_LD + hv0 * 16 + l15;
#pragma unroll
                for (int j = 0; j < 4; ++j) {
#pragma unroll
                    for (int i = 0; i < 4; ++i) hp[j * HO_LD + i * 16] = hacc[i][j]; }
            }
        }
        __syncthreads();
        {
            FRESH_IDS
            float hv[16];
#pragma unroll
            for (int q = 0; q < 4; ++q) { const f32x4 x = *(const LAS f32x4*)(HO + st * HO_LD + sp + q * 4); hv[q * 4] = x[0]; hv[q * 4 + 1] = x[1]; hv[q * 4 + 2] = x[2]; hv[q * 4 + 3] = x[3]; }
            float rs;
            if (KIND == 0) {
                float sm = 0.f;
#pragma unroll
                for (int j = 0; j < 16; ++j) sm += hv[j];
                sm += __shfl_xor(sm, 1); sm += __shfl_xor(sm, 2); sm += __shfl_xor(sm, 4);
                const float mean = sm * (1.f / 128.f); float sv = 0.f;
#pragma unroll
                for (int j = 0; j < 16; ++j) { hv[j] -= mean; sv += hv[j] * hv[j]; }
                sv += __shfl_xor(sv, 1); sv += __shfl_xor(sv, 2); sv += __shfl_xor(sv, 4);
                rs = rsqrtf(sv * (1.f / 128.f) + 1e-6f);
            } else {
                float sv = 0.f;
#pragma unroll
                for (int j = 0; j < 16; ++j) sv += hv[j] * hv[j];
                sv += __shfl_xor(sv, 1); sv += __shfl_xor(sv, 2); sv += __shfl_xor(sv, 4);
                rs = rsqrtf(sv * (1.f / 128.f) + 1e-6f);
            }
            const float* nwb = (KIND == 0 ? p.in[14] + layer * 1024 : p.in[16] + layer * 512) + head * 128; float nw[16];
#pragma unroll
            for (int q = 0; q < 4; ++q) { const f32x4 x = *(const f32x4*)(nwb + (unsigned)(sp + q * 4)); nw[q * 4] = x[0]; nw[q * 4 + 1] = x[1]; nw[q * 4 + 2] = x[2]; nw[q * 4 + 3] = x[3]; }
            const unsigned zw[8] = {pz[0].x, pz[0].y, pz[0].z, pz[0].w, pz[1].x, pz[1].y, pz[1].z, pz[1].w};
            unsigned ow[8] = {0, 0, 0, 0, 0, 0, 0, 0};
            if (KIND == 0) { ow[0] = po[0].x; ow[1] = po[0].y; ow[2] = po[0].z; ow[3] = po[0].w; ow[4] = po[1].x; ow[5] = po[1].y; ow[6] = po[1].z; ow[7] = po[1].w; }
            unsigned res[8];
#pragma unroll
            for (int j = 0; j < 8; ++j) { float o2[2];
#pragma unroll
                for (int h = 0; h < 2; ++h) { const int e = 2 * j + h; const float z = h ? bfhi(zw[j]) : bflo(zw[j]);
                    float o = hv[e] * rs * nw[e] * (z * sigmoidf_(z));
                    if (KIND == 0) { const float og = h ? bfhi(ow[j]) : bflo(ow[j]); o *= sigmoidf_(og); }
                    o2[h] = o; }
                res[j] = pk2(o2[0], o2[1]); }
            if (st < L) {
                bf16_t* Yb = KIND == 0 ? (bf16_t*)(p.ws + WS_BUFB) + (size_t)(row_base + t0) * 1024 + head * 128
                                       : (bf16_t*)(p.ws + WS_BUFB) + (size_t)MPAD * 1024 + (size_t)(row_base + t0) * 512 + head * 128;
                const unsigned yo = (unsigned)(st * (KIND == 0 ? 1024 : 512) + sp);
                *(u32x4*)(Yb + yo) = (u32x4){res[0], res[1], res[2], res[3]}; *(u32x4*)(Yb + 8 + yo) = (u32x4){res[4], res[5], res[6], res[7]};
            }
        }
        {
            FRESH_IDS
            float csc = w_old;
            if (KIND == 1) csc = __expf(GT[G_AEND + wid * 16 + l15]);
#pragma unroll
            for (int vt = 0; vt < NVT; ++vt) C[vt] *= csc;
            const LAS bf16_t* kp = KT + (wid * 16 + l15) * VT_LD + lq * 8; const LAS bf16_t* vp = VT + l15 * VT_LD + lq * 8;
#pragma unroll
            for (int kk = 0; kk < 2; ++kk) {
                const bf16x8 fb = *(const LAS bf16x8*)(kp + kk * 32);
#pragma unroll
                for (int vt = 0; vt < NVT; ++vt) { const bf16x8 fa = *(const LAS bf16x8*)(vp + vt * 16 * VT_LD + kk * 32); C[vt] = __builtin_amdgcn_mfma_f32_16x16x32_bf16(fa, fb, C[vt], 0, 0, 0); }
                __builtin_amdgcn_sched_barrier(0);
            }
            m_run = m_new;
        }
        __syncthreads();
    }
#undef CU_PREFETCH
    {
        FRESH_IDS
        if (KIND == 0) {
            float* Co = p.out + (sample ? O_CS : O_CP) + ((((size_t)layer * NB + bseq) * 8 + head) * 128) * 128;
#pragma unroll
            for (int vt = 0; vt < 8; ++vt)
#pragma unroll
                for (int j = 0; j < 4; ++j) Co[(unsigned)((vt * 16 + lq * 4 + j) * 128 + wid * 16 + l15)] = C[vt][j];
            if (lq == 0) (p.out + (sample ? O_NS : O_NP) + (((size_t)layer * NB + bseq) * 8 + head) * 128)[(unsigned)(wid * 16 + l15)] = C[NVT - 1][0];
            if (T_ == 0) p.out[(sample ? O_MS : O_MP) + ((size_t)layer * NB + bseq) * 8 + head] = m_run;
        } else {
            float* So = p.out + (sample ? O_HS : O_HP) + ((((size_t)layer * NB + bseq) * 4 + head) * 128) * 128;
#pragma unroll
            for (int vt = 0; vt < 8; ++vt) *(f32x4*)(So + (unsigned)((wid * 16 + l15) * 128 + vt * 16 + lq * 4)) = C[vt];
        }
    }
    __syncthreads();
}

__device__ void mixer_unit(const Params& p, int layer, int u, LAS unsigned char* lds) {
    int kind, v; bool sample;
    if (u < 64) { kind = 0; v = u; sample = false; }
    else if (u < 128) { kind = 1; v = u - 64; sample = false; }
    else if (u < 160) { kind = 2; v = u - 128; sample = false; }
    else if (u < 416) { kind = 1; v = u - 160; sample = true; }
    else if (u < 544) { kind = 2; v = u - 416; sample = true; }
    else { kind = 0; v = u - 544; sample = true; }
#ifndef SKIP_MIX_R
    if (kind == 0) rwkv_scan(p, layer, v >> 3, v & 7, sample, lds);
#endif
#ifndef SKIP_MIX_M
    if (kind == 1) chunk_unit<0>(p, layer, v >> 3, v & 7, sample, lds);
#endif
#ifndef SKIP_MIX_H
    if (kind == 2) chunk_unit<1>(p, layer, v >> 2, v & 3, sample, lds);
#endif
}
__device__ void mixer_phase(const Params& p, int layer, LAS unsigned char* lds, int bid, int nb) {
    constexpr int NU = 800, NLONG = 160;
    if (nb > NLONG + 32) {
        if (bid < NLONG) mixer_unit(p, layer, bid, lds);
        else for (int u = NLONG + (bid - NLONG); u < NU; u += nb - NLONG) mixer_unit(p, layer, u, lds);
    } else for (int u = bid; u < NU; u += nb) mixer_unit(p, layer, u, lds);
}

__global__ void __launch_bounds__(NTHREADS, 2) fwd_kernel(Params p) {
    extern __shared__ __attribute__((aligned(16))) unsigned char shm_[];
    LAS unsigned char* lds = (LAS unsigned char*)shm_;
    const int nb = gridDim.x;
    bf16_t* WTIN = (bf16_t*)(p.ws + WS_WTIN);
    bf16_t* BUFA = (bf16_t*)(p.ws + WS_BUFA); bf16_t* BUFB = (bf16_t*)(p.ws + WS_BUFB); bf16_t* PB = (bf16_t*)(p.ws + WS_P);
    for (int ph = p.ph_lo; ph < p.ph_hi; ++ph) {
        int bid = blockIdx.x; asm volatile("" : "+s"(bid));
        if (ph == 0) {
#ifndef SKIP_CONV
            convert_T(p.in[11], 2048, NIN, NINP, WTIN, (LAS float*)lds, bid, nb);
            for (int l = 0; l < 2; ++l) {
                bf16_t* wl = (bf16_t*)(p.ws + WS_WTS + (size_t)l * WTS_LAYER);
                convert_T(p.in[27] + (size_t)l * 1024 * 2048, 1024, 2048, 2048, wl, (LAS float*)lds, bid, nb);
                convert_T(p.in[28] + (size_t)l * 512 * 2048, 512, 2048, 2048, wl + (size_t)2048 * 1024, (LAS float*)lds, bid, nb);
                convert_T(p.in[29] + (size_t)l * 512 * 2048, 512, 2048, 2048, wl + (size_t)2048 * 1536, (LAS float*)lds, bid, nb);
                convert_T(p.in[30] + (size_t)l * 2048 * 2048, 2048, 2048, 2048, wl + (size_t)2048 * 2048, (LAS float*)lds, bid, nb);
            }
#endif
#ifndef SKIP_NORM
            prenorm0(p, bid, nb);
#endif
        } else {
            const int layer = (ph - 1) / 6, sub = (ph - 1) % 6;
            bf16_t* wl = (bf16_t*)(p.ws + WS_WTS + (size_t)layer * WTS_LAYER);
            if (sub == 0) {
                pg8::Gemm g{BUFA, WTIN, MPAD, NINP, 2048}; pg8::StaticOrder S; S.init(MPAD, NINP, nb, bid);
                pg8::EpiStore E{PB, NINP};
#ifndef SKIP_G1
                pg8::gemm_phase(lds, g, S, E);
#endif
            } else if (sub == 1) {
#ifndef SKIP_PREP
                rwkv_prep(p, layer, lds, bid, nb);
#endif
            } else if (sub == 2) {
#ifndef SKIP_MIX
                mixer_phase(p, layer, lds, bid, nb);
#endif
            } else if (sub == 3) {
#ifndef SKIP_G2
                pg8::StaticOrder S; S.init(MPAD, 2048, nb, bid);
                { pg8::Gemm g{BUFB, wl, MPAD, 2048, 1024}; pg8::EpiGate<0> E{BUFA, PB + G_BASE}; pg8::gemm_phase(lds, g, S, E); }
                { pg8::Gemm g{BUFB + (size_t)MPAD * 1024, wl + (size_t)2048 * 1024, MPAD, 2048, 512}; pg8::EpiGate<1> E{BUFA, PB + G_BASE + 2048}; pg8::gemm_phase(lds, g, S, E); }
                { pg8::Gemm g{BUFB + (size_t)MPAD * 1536, wl + (size_t)2048 * 1536, MPAD, 2048, 512}; pg8::EpiGate<1> E{BUFA, PB + G_BASE + 4096}; pg8::gemm_phase(lds, g, S, E); }
#endif
            } else if (sub == 4) {
                pg8::Gemm g{BUFA, wl + (size_t)2048 * 2048, MPAD, 2048, 2048}; pg8::StaticOrder S; S.init(MPAD, 2048, nb, bid);
                pg8::EpiStore E{BUFB, 2048};
#ifndef SKIP_G3
                pg8::gemm_phase(lds, g, S, E);
#endif
            } else {
#ifndef SKIP_CONV
                if (layer == 0) convert_T(p.in[11] + (size_t)2048 * NIN, 2048, NIN, NINP, WTIN, (LAS float*)lds, bid, nb);
#endif
#ifndef SKIP_NORM
                postnorm(p, layer, bid, nb);
#endif
            }
        }
        if (ph + 1 < p.ph_hi) { if (p.coop) cg::this_grid().sync(); }
    }
}

extern "C" void kernel_launch(void* const* d_in, const int* in_sizes, int n_in, void* d_out, int out_size, void* d_ws, size_t ws_size, hipStream_t stream) {
    static int grid = 0;
    if (grid == 0) {
        if (n_in != 31 || ws_size < WS_END || (size_t)out_size != O_END) { fprintf(stderr, "kernel_launch: unexpected shapes: n_in %d out %d ws %zu (need %zu)\n", n_in, out_size, ws_size, (size_t)WS_END); grid = -1; return; }
        int dev = 0, cus = 0, per_cu = 0;
        hipGetDevice(&dev); hipDeviceGetAttribute(&cus, hipDeviceAttributeMultiprocessorCount, dev);
        if (hipFuncSetAttribute((const void*)fwd_kernel, hipFuncAttributeMaxDynamicSharedMemorySize, LDS_BYTES) != hipSuccess) { fprintf(stderr, "kernel_launch: hipFuncSetAttribute failed\n"); grid = -1; return; }
        if (hipOccupancyMaxActiveBlocksPerMultiprocessor(&per_cu, (const void*)fwd_kernel, NTHREADS, LDS_BYTES) != hipSuccess || per_cu < 1) { fprintf(stderr, "kernel_launch: occupancy query says %d\n", per_cu); per_cu = 1; }
        (void)hipGetLastError();
        grid = cus * per_cu;
    }
    if (grid < 0) return;
    Params p{};
    for (int i = 0; i < 31; ++i) p.in[i] = (const float*)d_in[i];
    p.out = (float*)d_out; p.ws = (unsigned char*)d_ws; p.pad = 0;
#ifdef MULTI_LAUNCH
    p.coop = 0;
    for (int ph = 0; ph < 13; ++ph) { p.ph_lo = ph; p.ph_hi = ph + 1; hipLaunchKernelGGL(fwd_kernel, dim3(grid), dim3(NTHREADS), LDS_BYTES, stream, p); }
#else
    p.coop = 1; p.ph_lo = 0; p.ph_hi = 13;
    void* args[] = {&p};
    hipError_t e = hipLaunchCooperativeKernel((const void*)fwd_kernel, dim3(grid), dim3(NTHREADS), args, LDS_BYTES, stream);
    if (e != hipSuccess) fprintf(stderr, "cooperative launch failed: %s (grid %d)\n", hipGetErrorString(e), grid);
#endif
}
```

```cpp
#include <hip/hip_runtime.h>
#include <hip/hip_cooperative_groups.h>
#include <cstdio>
namespace cg = cooperative_groups;

#define LAS __attribute__((address_space(3)))
typedef unsigned short bf16_t;
typedef short bf16x8 __attribute__((ext_vector_type(8)));
typedef float f32x4 __attribute__((ext_vector_type(4)));
typedef float f32x2 __attribute__((ext_vector_type(2)));
typedef unsigned u32x4 __attribute__((ext_vector_type(4)));
typedef unsigned u32x2 __attribute__((ext_vector_type(2)));

constexpr int DM = 2048, MROWS = 18560, MPAD = 18688, NP_ROWS = 16512, TP = 2064;
constexpr int NIN = 15504, NINP = 15616;
constexpr int A_Q = 0, A_K = 1024, A_V = 2048, A_I = 3072, A_F = 3080, A_O = 3088, A_Z = 4112;
constexpr int B_Q = 5136, B_F = 5648, B_I = 6160, B_Z = 6672;
constexpr int C_BASE = 7184, C_COLS = 2176;
constexpr int CO_R = 0, CO_K = 512, CO_V = 1024, CO_WD = 1536, CO_AD = 1600, CO_Z = 1664;
constexpr int G_BASE = 9360;
constexpr int LDS_BYTES = 163840;
constexpr int NTHREADS = 512;

constexpr size_t O_YP = 0, O_YS = 33554432, O_CP = O_YS + 4194304, O_NP = O_CP + 2097152, O_MP = O_NP + 16384, O_HP = O_MP + 128,
                 O_RP = O_HP + 1048576, O_SHP = O_RP + 524288, O_CS = O_SHP + 34816, O_NS = O_CS + 8388608, O_MS = O_NS + 65536,
                 O_HS = O_MS + 512, O_RS = O_HS + 4194304, O_SHS = O_RS + 2097152, O_END = O_SHS + 139264;

constexpr size_t WS_WTIN = 0;
constexpr size_t WS_WTS = WS_WTIN + (size_t)NINP * 2048 * 2;
constexpr size_t WTS_LAYER = (size_t)2048 * 4096 * 2;
constexpr size_t WS_BUFA = WS_WTS + 2 * WTS_LAYER;
constexpr size_t BUF_BYTES = (size_t)MPAD * 2048 * 2;
constexpr size_t WS_BUFB = WS_BUFA + BUF_BYTES;
constexpr size_t WS_P = WS_BUFB + BUF_BYTES;
constexpr size_t WS_RX = WS_P + (size_t)MPAD * NINP * 2;
constexpr size_t RARR = (size_t)MPAD * 512 * 2;
constexpr size_t WS_XMETA = WS_RX + 4 * RARR;
constexpr size_t WS_YRAW = WS_XMETA + (size_t)8 * 16 * 2048 * 4;
constexpr size_t WS_CTR = WS_YRAW + (size_t)MPAD * 512 * 4;
constexpr size_t WS_END = WS_CTR + 256;

struct Params {
    const float* in[31];
    float* out;
    unsigned char* ws;
    int ph_lo, ph_hi, coop, pad;
};

__device__ __forceinline__ float bf2f(bf16_t x) { return __uint_as_float(((unsigned)x) << 16); }
__device__ __forceinline__ float bflo(unsigned w) { return __uint_as_float(w << 16); }
__device__ __forceinline__ float bfhi(unsigned w) { return __uint_as_float(w & 0xffff0000u); }
__device__ __forceinline__ bf16_t f2bf(float f) { unsigned u = __float_as_uint(f); u += 0x7FFFu + ((u >> 16) & 1u); return (bf16_t)(u >> 16); }
__device__ __forceinline__ unsigned pk2(float lo, float hi) { return (unsigned)f2bf(lo) | ((unsigned)f2bf(hi) << 16); }
__device__ __forceinline__ float sigmoidf_(float x) { return __builtin_amdgcn_rcpf(1.0f + __expf(-x)); }
__device__ __forceinline__ float logsigmoidf_(float x) { return fminf(x, 0.f) - __logf(1.0f + __expf(-fabsf(x))); }
__device__ __forceinline__ float wave_sum(float v) {
#pragma unroll
    for (int d = 32; d >= 1; d >>= 1) v += __shfl_xor(v, d);
    return v;
}
template <int CTRL> __device__ __forceinline__ float dppf(float v) { return __int_as_float(__builtin_amdgcn_update_dpp(0, __float_as_int(v), CTRL, 0xf, 0xf, true)); }
__device__ __forceinline__ float row16_sum(float v) {
    v += dppf<0xB1>(v); v += dppf<0x4E>(v); v += dppf<0x141>(v); v += dppf<0x140>(v); return v;
}

__device__ __forceinline__ int fresh_tid() { int t = threadIdx.x; asm volatile("" : "+v"(t)); return t; }
__device__ __forceinline__ float wave_sum_fast(float v) {
    v = row16_sum(v); const int iv = __float_as_int(v);
    return (__int_as_float(__builtin_amdgcn_readlane(iv, 0)) + __int_as_float(__builtin_amdgcn_readlane(iv, 16))) + (__int_as_float(__builtin_amdgcn_readlane(iv, 32)) + __int_as_float(__builtin_amdgcn_readlane(iv, 48)));
}
__device__ __forceinline__ const float* x0_row(const Params& p, int r) {
    if (r < NP_ROWS) { const int b = r / TP, t = r - b * TP; return t < 16 ? p.in[8] + (size_t)t * DM : p.in[0] + ((size_t)b * 2048 + (t - 16)) * DM; }
    return p.in[1] + (size_t)(r - NP_ROWS) * DM;
}
__device__ __forceinline__ float* x1_row(const Params& p, int r) {
    if (r < NP_ROWS) { const int b = r / TP, t = r - b * TP; return t < 16 ? (float*)(p.ws + WS_XMETA) + ((size_t)b * 16 + t) * DM : p.out + O_YP + ((size_t)b * 2048 + (t - 16)) * DM; }
    return p.out + O_YS + (size_t)(r - NP_ROWS) * DM;
}

namespace pg8 {
constexpr int BM = 256, BK = 64, HALF = 128, HTB = HALF * BK * 2, STAGE_BYTES = 8 * HTB, NXCD = 8, WGM = 8;
__device__ __forceinline__ int lds_byte(int r, int c) { const int st = (r >> 4) * 2 + (c >> 5), rr = r & 15, cc = c & 31, ob = rr * 64 + cc * 2; return st * 1024 + (ob ^ (((ob >> 9) & 1) << 5)); }
__device__ __forceinline__ void stage_rc(int b, int& R, int& C) { const int st = b / 1024, sb = b % 1024, swz = sb ^ (((sb >> 9) & 1) << 5); R = (st >> 1) * 16 + swz / 64; C = (st & 1) * 32 + (swz % 64) / 2; }
__device__ __forceinline__ int perm32(int rho) { const int n = rho >> 4, i = rho & 15; return 8 * (i >> 2) + 4 * n + (i & 3); }
struct Unit { int pm, pn; };
struct Gemm { const bf16_t* A; const bf16_t* Bt; int M, N, K; };
struct StaticOrder {
    int nM, nN, nwg, G, c;
    __device__ void init(int M, int N, int G_, int c_) { nM = M / BM; nN = N / BM; nwg = nM * nN; G = G_; c = c_; }
    __device__ bool next(int i, Unit& u) const {
        const long L = (long)i * G + c; if (L >= nwg) return false;
        int wgid = (int)L; { const int q = nwg / NXCD, r = nwg % NXCD, xcd = wgid % NXCD, off = wgid / NXCD; wgid = (xcd < r ? xcd * (q + 1) : r * (q + 1) + (xcd - r) * q) + off; }
        const int nig = WGM * nN, gid = wgid / nig, fm = gid * WGM, gsz = (nM - fm) < WGM ? (nM - fm) : WGM;
        u.pm = fm + ((wgid % nig) % gsz); u.pn = (wgid % nig) / gsz; return true;
    }
    __device__ __forceinline__ void a_ready(const Unit&) const {}
    __device__ __forceinline__ void done(const Unit&) const {}
};
__device__ __forceinline__ unsigned cvt_pk_bf16(float lo, float hi) { unsigned r; asm volatile("v_cvt_pk_bf16_f32 %0, %1, %2" : "=v"(r) : "v"(lo), "v"(hi)); return r; }

template <bool SIG> struct EpiStoreT {
    static constexpr bool PERM = true, HOOK = false;
    bf16_t* O; int ldc;
    __device__ __forceinline__ void mid(f32x4 (&acc)[2][2][4][2], const Unit& u, int wr, int wc, int fr, int fq, int which) const {}
    __device__ __forceinline__ void operator()(f32x4 (&acc)[2][2][4][2], const Unit& u, int wr, int wc, int fr, int fq) const {
        const int row0 = u.pm * BM + wr * 64 + fr, col0 = u.pn * BM + wc * 32 + 8 * fq;
#pragma unroll
        for (int bj = 0; bj < 2; ++bj) {
            const bool sg = SIG && (col0 + bj * HALF >= G_BASE);
#pragma unroll
            for (int ai = 0; ai < 2; ++ai)
#pragma unroll
                for (int m = 0; m < 4; ++m) { bf16_t* rowp = O + (size_t)(row0 + ai * HALF + m * 16) * ldc + col0;
                    f32x4 v0 = acc[ai][bj][m][0], v1 = acc[ai][bj][m][1];
                    if (sg) {
#pragma unroll
                        for (int j = 0; j < 4; ++j) { v0[j] = sigmoidf_(v0[j]); v1[j] = sigmoidf_(v1[j]); } }
                    u32x4 w; w.x = cvt_pk_bf16(v0[0], v0[1]); w.y = cvt_pk_bf16(v0[2], v0[3]); w.z = cvt_pk_bf16(v1[0], v1[1]); w.w = cvt_pk_bf16(v1[2], v1[3]);
                    *(u32x4*)(rowp + bj * HALF) = w; }
        }
    }
};
struct EpiGate3 {
    static constexpr bool PERM = true, HOOK = true;
    bf16_t* O; const bf16_t* SG;
    __device__ __forceinline__ void mid(f32x4 (&acc)[2][2][4][2], const Unit& u, int wr, int wc, int fr, int fq, int which) const {
        const int row0 = u.pm * BM + wr * 64 + fr, col0 = u.pn * BM + wc * 32 + 8 * fq;
        const bf16_t* gn = SG + which * 2048; const bf16_t* gd = SG + (which + 1) * 2048;
#pragma unroll
        for (int ai = 0; ai < 2; ++ai)
#pragma unroll
            for (int m = 0; m < 4; ++m) { const unsigned ro = (unsigned)(row0 + ai * HALF + m * 16) * (unsigned)NINP + (unsigned)col0;
#pragma unroll
                for (int bj = 0; bj < 2; ++bj) {
                    const u32x4 a = *(const u32x4*)(gn + ro + bj * HALF), b = *(const u32x4*)(gd + ro + bj * HALF);
                    f32x4& v0 = acc[ai][bj][m][0]; f32x4& v1 = acc[ai][bj][m][1];
                    v0[0] *= bflo(a.x) * __builtin_amdgcn_rcpf(bflo(b.x)); v0[1] *= bfhi(a.x) * __builtin_amdgcn_rcpf(bfhi(b.x));
                    v0[2] *= bflo(a.y) * __builtin_amdgcn_rcpf(bflo(b.y)); v0[3] *= bfhi(a.y) * __builtin_amdgcn_rcpf(bfhi(b.y));
                    v1[0] *= bflo(a.z) * __builtin_amdgcn_rcpf(bflo(b.z)); v1[1] *= bfhi(a.z) * __builtin_amdgcn_rcpf(bfhi(b.z));
                    v1[2] *= bflo(a.w) * __builtin_amdgcn_rcpf(bflo(b.w)); v1[3] *= bfhi(a.w) * __builtin_amdgcn_rcpf(bfhi(b.w));
                    asm volatile("" ::: "memory"); } }
    }
    __device__ __forceinline__ void operator()(f32x4 (&acc)[2][2][4][2], const Unit& u, int wr, int wc, int fr, int fq) const {
        const int row0 = u.pm * BM + wr * 64 + fr, col0 = u.pn * BM + wc * 32 + 8 * fq;
        const bf16_t* gc = SG + 4096;
#pragma unroll
        for (int ai = 0; ai < 2; ++ai)
#pragma unroll
            for (int m = 0; m < 4; ++m) { const unsigned rr = (unsigned)(row0 + ai * HALF + m * 16);
#pragma unroll
                for (int bj = 0; bj < 2; ++bj) { const f32x4 v0 = acc[ai][bj][m][0], v1 = acc[ai][bj][m][1];
                    const u32x4 g = *(const u32x4*)(gc + rr * (unsigned)NINP + col0 + bj * HALF);
                    u32x4 w; w.x = cvt_pk_bf16(v0[0] * bflo(g.x), v0[1] * bfhi(g.x)); w.y = cvt_pk_bf16(v0[2] * bflo(g.y), v0[3] * bfhi(g.y));
                    w.z = cvt_pk_bf16(v1[0] * bflo(g.z), v1[1] * bfhi(g.z)); w.w = cvt_pk_bf16(v1[2] * bflo(g.w), v1[3] * bfhi(g.w));
                    *(u32x4*)(O + rr * (unsigned)DM + col0 + bj * HALF) = w; asm volatile("" ::: "memory"); } }
    }
};

template <class Epi, class Sched>
__device__ __forceinline__ void gemm_phase(LAS unsigned char* lds, const Gemm g, const Sched& S, const Epi& E) {
    const int tid = fresh_tid(), wid = __builtin_amdgcn_readfirstlane(tid >> 6), lane = tid & 63, wr = wid >> 2, wc = wid & 3, fr = lane & 15, fq = lane >> 4;
    const int K = g.K, nt = K / BK;
    unsigned voffA[2], voffB[2];
#pragma unroll
    for (int i = 0; i < 2; ++i) { int R, C; stage_rc(tid * 16 + i * 8192, R, C); const int Rb = Epi::PERM ? ((R & ~31) + perm32(R & 31)) : R;
        voffA[i] = (unsigned)(R * K + C) * 2u; voffB[i] = (unsigned)(Rb * K + C) * 2u; }
    const size_t kstep = (size_t)(BK * 2);
    const size_t hstep = (size_t)HALF * K * 2;
    const size_t tstep = 2 * hstep;
    const unsigned ldsw = (unsigned)wid * 1024u;
    const int aoff = lds_byte(wr * 64 + fr, fq * 8), boff = lds_byte(wc * 32 + fr, fq * 8);
#define PG8_SA(b, h) (((b) * 2 + (h)) * HTB)
#define PG8_SB(b, h) ((4 + (b) * 2 + (h)) * HTB)
#define PG8_STAGE(bufoff, gbase, voff) do { _Pragma("unroll") for (int _i = 0; _i < 2; ++_i) \
        __builtin_amdgcn_global_load_lds((const unsigned*)((const char*)(gbase) + (voff)[_i]), (LAS unsigned*)(lds + (bufoff) + ldsw + _i * 8192), 16, 0, 0); } while (0)
#define PG8_LDA(dst, b, h) do { _Pragma("unroll") for (int m = 0; m < 4; ++m) _Pragma("unroll") for (int k = 0; k < 2; ++k) dst[m][k] = *(const LAS bf16x8*)(lds + PG8_SA(b, h) + aoff + m * 2048 + k * 1024); } while (0)
#define PG8_LDB(dst, b, h) do { _Pragma("unroll") for (int n = 0; n < 2; ++n) _Pragma("unroll") for (int k = 0; k < 2; ++k) dst[n][k] = *(const LAS bf16x8*)(lds + PG8_SB(b, h) + boff + n * 2048 + k * 1024); } while (0)
#define PG8_MMA(ai, bj, At, Bt) do { __builtin_amdgcn_s_setprio(1); _Pragma("unroll") for (int m = 0; m < 4; ++m) _Pragma("unroll") for (int n = 0; n < 2; ++n) _Pragma("unroll") for (int k = 0; k < 2; ++k) \
        acc[ai][bj][m][n] = __builtin_amdgcn_mfma_f32_16x16x32_bf16(Bt[n][k], At[m][k], acc[ai][bj][m][n], 0, 0, 0); __builtin_amdgcn_s_setprio(0); } while (0)
#define PG8_WAIT_V(n) asm volatile("s_waitcnt vmcnt(" #n ")" ::: "memory")
#define PG8_WAIT_L(n) asm volatile("s_waitcnt lgkmcnt(" #n ")" ::: "memory")
#define PG8_BAR __builtin_amdgcn_s_barrier()
#define PG8_SCHED __builtin_amdgcn_sched_barrier(0)
    Unit cur, nxt; int ui = 0;
    if (!S.next(0, cur)) return;
    f32x4 acc[2][2][4][2];
#pragma unroll
    for (int a = 0; a < 2; ++a)
#pragma unroll
        for (int b = 0; b < 2; ++b)
#pragma unroll
            for (int m = 0; m < 4; ++m)
#pragma unroll
                for (int n = 0; n < 2; ++n) acc[a][b][m][n] = (f32x4){0.f, 0.f, 0.f, 0.f};
    bf16x8 At[4][2], B0[2][2], B1[2][2];
    const char* cA = (const char*)g.A + (size_t)cur.pm * tstep; const char* cB = (const char*)g.Bt + (size_t)cur.pn * tstep;
    S.a_ready(cur);
    PG8_STAGE(PG8_SB(0, 0), cB, voffB); PG8_STAGE(PG8_SA(0, 0), cA, voffA); PG8_STAGE(PG8_SB(0, 1), cB + hstep, voffB); PG8_STAGE(PG8_SA(0, 1), cA + hstep, voffA);
    if (wr == 1) PG8_BAR;
    PG8_WAIT_V(4); PG8_BAR;
    PG8_STAGE(PG8_SB(1, 0), cB + kstep, voffB); PG8_STAGE(PG8_SA(1, 0), cA + kstep, voffA); PG8_STAGE(PG8_SB(1, 1), cB + hstep + kstep, voffB);
    PG8_WAIT_V(6); PG8_BAR;
    for (;;) {
        const bool has_next = S.next(ui + 1, nxt);
        const char* nA = has_next ? (const char*)g.A + (size_t)nxt.pm * tstep : cA; const char* nB = has_next ? (const char*)g.Bt + (size_t)nxt.pn * tstep : cB;
        for (int t = 0; t < nt; t += 2) {
            const bool last = (t == nt - 2);
            const char* a1 = cA + (size_t)(t + 1) * kstep;
            const char* a2 = last ? nA : cA + (size_t)(t + 2) * kstep; const char* b2 = last ? nB : cB + (size_t)(t + 2) * kstep;
            const char* a3 = a2 + kstep; const char* b3 = b2 + kstep;
            if (last && has_next) S.a_ready(nxt);
            if (Epi::HOOK && (t == 16 || t == 24)) E.mid(acc, cur, wr, wc, fr, fq, t == 16 ? 0 : 1);
            PG8_LDB(B0, 0, 0); PG8_SCHED; PG8_LDA(At, 0, 0); PG8_STAGE(PG8_SA(1, 1), a1 + hstep, voffA);
            PG8_WAIT_L(8); PG8_BAR; PG8_WAIT_L(0); PG8_MMA(0, 0, At, B0); PG8_BAR; PG8_SCHED;
            PG8_LDB(B1, 0, 1); PG8_STAGE(PG8_SB(0, 0), b2, voffB);
            PG8_BAR; PG8_WAIT_L(0); PG8_MMA(0, 1, At, B1); PG8_BAR;
            PG8_LDA(At, 0, 1); PG8_STAGE(PG8_SA(0, 0), a2, voffA);
            PG8_BAR; PG8_WAIT_L(0); PG8_MMA(1, 0, At, B0); PG8_BAR; PG8_SCHED;
            PG8_STAGE(PG8_SB(0, 1), b2 + hstep, voffB);
            PG8_WAIT_V(6); PG8_BAR; PG8_MMA(1, 1, At, B1); PG8_BAR;
            PG8_LDB(B0, 1, 0); PG8_SCHED; PG8_LDA(At, 1, 0); PG8_STAGE(PG8_SA(0, 1), a2 + hstep, voffA);
            PG8_WAIT_L(8); PG8_BAR; PG8_WAIT_L(0); PG8_MMA(0, 0, At, B0); PG8_BAR; PG8_SCHED;
            PG8_LDB(B1, 1, 1); PG8_STAGE(PG8_SB(1, 0), b3, voffB);
            PG8_BAR; PG8_WAIT_L(0); PG8_MMA(0, 1, At, B1); PG8_BAR;
            PG8_LDA(At, 1, 1); PG8_STAGE(PG8_SA(1, 0), a3, voffA);
            PG8_BAR; PG8_WAIT_L(0); PG8_MMA(1, 0, At, B0); PG8_BAR; PG8_SCHED;
            PG8_STAGE(PG8_SB(1, 1), b3 + hstep, voffB);
            PG8_WAIT_V(6); PG8_BAR; PG8_MMA(1, 1, At, B1); PG8_BAR;
        }
        E(acc, cur, wr, wc, fr, fq); S.done(cur);
        if (!has_next) break;
#pragma unroll
        for (int a = 0; a < 2; ++a)
#pragma unroll
            for (int b = 0; b < 2; ++b)
#pragma unroll
                for (int m = 0; m < 4; ++m)
#pragma unroll
                    for (int n = 0; n < 2; ++n) acc[a][b][m][n] = (f32x4){0.f, 0.f, 0.f, 0.f};
        cur = nxt; cA = nA; cB = nB; ++ui;
    }
    PG8_WAIT_V(0);
    if (wr == 0) PG8_BAR;
    PG8_BAR;
#undef PG8_SA
#undef PG8_SB
#undef PG8_STAGE
#undef PG8_LDA
#undef PG8_LDB
#undef PG8_MMA
#undef PG8_WAIT_V
#undef PG8_WAIT_L
#undef PG8_BAR
#undef PG8_SCHED
}
}

__device__ void convert_T(const float* __restrict__ W, int K, int N, int Npad, bf16_t* __restrict__ Wt, int ldw, LAS float* tile, int t0, int tstride) {
    const int tid = fresh_tid(), tk = K / 64, tn = Npad / 64;
    for (int t = t0; t < tk * tn; t += tstride) {
        const int k0 = (t % tk) * 64, n0 = (t / tk) * 64;
#pragma unroll
        for (int i = 0; i < 2; ++i) { const int k = (tid >> 4) + 32 * i, n = (tid & 15) * 4;
            f32x4 v = (f32x4){0.f, 0.f, 0.f, 0.f};
            if (n0 + n < N) v = *(const f32x4*)(W + (size_t)(k0 + k) * N + n0 + n);
            tile[k * 65 + n] = v[0]; tile[k * 65 + n + 1] = v[1]; tile[k * 65 + n + 2] = v[2]; tile[k * 65 + n + 3] = v[3]; }
        __syncthreads();
        { const int n = tid >> 3, k8 = (tid & 7) * 8; u32x4 w;
          w.x = pk2(tile[(k8 + 0) * 65 + n], tile[(k8 + 1) * 65 + n]); w.y = pk2(tile[(k8 + 2) * 65 + n], tile[(k8 + 3) * 65 + n]);
          w.z = pk2(tile[(k8 + 4) * 65 + n], tile[(k8 + 5) * 65 + n]); w.w = pk2(tile[(k8 + 6) * 65 + n], tile[(k8 + 7) * 65 + n]);
          *(u32x4*)(Wt + (size_t)(n0 + n) * ldw + k0 + k8) = w; }
        __syncthreads();
    }
}

__device__ void prenorm0(const Params& p, int bid, int nb) {
    const int tid_ = fresh_tid(); const int lane = tid_ & 63, wid = tid_ >> 6;
    bf16_t* H = (bf16_t*)(p.ws + WS_BUFA);
    const float* g = p.in[9];
    for (int r = bid * 8 + wid; r < MROWS; r += nb * 8) {
        const float* x = x0_row(p, r);
        f32x4 v[8]; float ss = 0.f;
#pragma unroll
        for (int i = 0; i < 8; ++i) { v[i] = *(const f32x4*)(x + i * 256 + lane * 4); ss += v[i][0] * v[i][0] + v[i][1] * v[i][1] + v[i][2] * v[i][2] + v[i][3] * v[i][3]; }
        ss = wave_sum(ss);
        const float rs = rsqrtf(ss * (1.0f / DM) + 1e-6f);
#pragma unroll
        for (int i = 0; i < 8; ++i) { const f32x4 gg = *(const f32x4*)(g + i * 256 + lane * 4);
            u32x2 w; w.x = pk2(v[i][0] * rs * gg[0], v[i][1] * rs * gg[1]); w.y = pk2(v[i][2] * rs * gg[2], v[i][3] * rs * gg[3]);
            *(u32x2*)(H + (size_t)r * DM + i * 256 + lane * 4) = w; }
    }
}
__device__ void postnorm(const Params& p, int layer, int bid, int nb) {
    const int tid_ = fresh_tid(); const int lane = tid_ & 63, wid = tid_ >> 6;
    const bf16_t* Y = (const bf16_t*)(p.ws + WS_BUFB);
    bf16_t* H = (bf16_t*)(p.ws + WS_BUFA);
    const float* gpost = p.in[10] + layer * DM;
    const float* gpre = p.in[9] + DM;
    for (int r = bid * 8 + wid; r < MROWS; r += nb * 8) {
        const float* x = layer == 0 ? x0_row(p, r) : x1_row(p, r);
        float* xo = x1_row(p, r);
        float yv[32]; float ss = 0.f;
#pragma unroll
        for (int i = 0; i < 4; ++i) { const u32x4 w = *(const u32x4*)(Y + (size_t)r * DM + i * 512 + lane * 8);
            yv[i * 8 + 0] = bflo(w.x); yv[i * 8 + 1] = bfhi(w.x); yv[i * 8 + 2] = bflo(w.y); yv[i * 8 + 3] = bfhi(w.y);
            yv[i * 8 + 4] = bflo(w.z); yv[i * 8 + 5] = bfhi(w.z); yv[i * 8 + 6] = bflo(w.w); yv[i * 8 + 7] = bfhi(w.w); }
#pragma unroll
        for (int i = 0; i < 32; ++i) ss += yv[i] * yv[i];
        ss = wave_sum(ss);
        const float rs = rsqrtf(ss * (1.0f / DM) + 1e-6f);
        float s2 = 0.f;
#pragma unroll
        for (int i = 0; i < 4; ++i)
#pragma unroll
            for (int h = 0; h < 2; ++h) { const int c = i * 512 + lane * 8 + h * 4;
                const f32x4 xv = *(const f32x4*)(x + c); const f32x4 gg = *(const f32x4*)(gpost + c);
                f32x4 o;
#pragma unroll
                for (int j = 0; j < 4; ++j) { o[j] = xv[j] + yv[i * 8 + h * 4 + j] * rs * gg[j]; s2 += o[j] * o[j]; yv[i * 8 + h * 4 + j] = o[j]; }
                *(f32x4*)(xo + c) = o; }
        if (layer == 0) {
            s2 = wave_sum(s2);
            const float r2 = rsqrtf(s2 * (1.0f / DM) + 1e-6f);
#pragma unroll
            for (int i = 0; i < 4; ++i) { const int c = i * 512 + lane * 8;
                const f32x4 g0 = *(const f32x4*)(gpre + c), g1 = *(const f32x4*)(gpre + c + 4);
                u32x4 w; w.x = pk2(yv[i * 8 + 0] * r2 * g0[0], yv[i * 8 + 1] * r2 * g0[1]); w.y = pk2(yv[i * 8 + 2] * r2 * g0[2], yv[i * 8 + 3] * r2 * g0[3]);
                w.z = pk2(yv[i * 8 + 4] * r2 * g1[0], yv[i * 8 + 5] * r2 * g1[1]); w.w = pk2(yv[i * 8 + 6] * r2 * g1[2], yv[i * 8 + 7] * r2 * g1[3]);
                *(u32x4*)(H + (size_t)r * DM + c) = w; }
        }
    }
}

__device__ __forceinline__ bf16_t* rarr(const Params& p, int i) { return (bf16_t*)(i < 4 ? p.ws + WS_BUFA + (size_t)i * RARR : p.ws + WS_RX + (size_t)(i - 4) * RARR); }
__device__ void rwkv_prep(const Params& p, int layer, LAS unsigned char* lds, int bid, int nb) {
    const int tid = fresh_tid();
    LAS bf16_t* PC = (LAS bf16_t*)lds;
    LAS float* XW = (LAS float*)(lds + 17 * C_COLS * 2);
    LAS float* XA = XW + 16 * 64;
    const bf16_t* P = (const bf16_t*)(p.ws + WS_P);
    const float* mu = p.in[17] + layer * C_COLS;
    const float* w0 = p.in[18] + layer * 512; const float* wup = p.in[19] + (size_t)layer * 64 * 512;
    const float* a0 = p.in[20] + layer * 512; const float* aup = p.in[21] + (size_t)layer * 64 * 512;
    const float kkc = p.in[22][layer * 512 + tid], kac = p.in[23][layer * 512 + tid], rkc = p.in[24][layer * 512 + tid];
    bf16_t* oR = rarr(p, 0); bf16_t* oU = rarr(p, 1); bf16_t* oK = rarr(p, 2); bf16_t* oV = rarr(p, 3);
    bf16_t* oKK = rarr(p, 4); bf16_t* oKA = rarr(p, 5); bf16_t* oZS = rarr(p, 6); bf16_t* oBV = rarr(p, 7);
    for (int tile = bid; tile < MROWS / 16; tile += nb) {
        const int r0 = tile * 16;
        int seq_t0, seq_T, sb; bool sample;
        if (r0 < NP_ROWS) { sb = r0 / TP; seq_t0 = r0 - sb * TP; seq_T = TP; sample = false; } else { sb = (r0 - NP_ROWS) / 64; seq_t0 = (r0 - NP_ROWS) - sb * 64; seq_T = 64; sample = true; }
        for (int i = tid; i < 17 * (C_COLS / 8); i += NTHREADS) { const int rr = i / (C_COLS / 8), cc = (i - rr * (C_COLS / 8)) * 8;
            u32x4 v = (u32x4){0u, 0u, 0u, 0u};
            if (rr > 0 || seq_t0 > 0) v = *(const u32x4*)(P + (size_t)(r0 - 1 + rr) * NINP + C_BASE + cc);
            else if (sample) { const float* sh = p.in[7] + ((size_t)layer * 32 + sb) * C_COLS + cc;
                v.x = pk2(sh[0], sh[1]); v.y = pk2(sh[2], sh[3]); v.z = pk2(sh[4], sh[5]); v.w = pk2(sh[6], sh[7]); }
            *(LAS u32x4*)(PC + rr * C_COLS + cc) = v; }
        __syncthreads();
        for (int i = tid; i < 16 * 128; i += NTHREADS) { const int tok = i >> 7, j = i & 127, col = CO_WD + j;
            const float pc = bf2f(PC[(tok + 1) * C_COLS + col]), pv = bf2f(PC[tok * C_COLS + col]);
            const float xs = pc + mu[col] * (pv - pc);
            if (j < 64) { const float e = __expf(2.f * xs); XW[tok * 64 + j] = 1.f - 2.f * __builtin_amdgcn_rcpf(e + 1.f); } else XA[tok * 64 + (j - 64)] = xs; }
        if (seq_t0 + 16 == seq_T) { float* so = p.out + (sample ? O_SHS + ((size_t)layer * 32 + sb) * C_COLS : O_SHP + ((size_t)layer * 8 + sb) * C_COLS);
            for (int i = tid; i < C_COLS; i += NTHREADS) so[i] = bf2f(PC[16 * C_COLS + i]); }
        __syncthreads();
        float aw[16], aa[16];
#pragma unroll
        for (int t = 0; t < 16; ++t) { aw[t] = 0.f; aa[t] = 0.f; }
        for (int j = 0; j < 64; j += 4) {
            float wu[4], au[4];
#pragma unroll
            for (int q = 0; q < 4; ++q) { wu[q] = wup[(size_t)(j + q) * 512 + tid]; au[q] = aup[(size_t)(j + q) * 512 + tid]; }
#pragma unroll
            for (int t = 0; t < 16; ++t) { const f32x4 xw = *(const LAS f32x4*)(XW + t * 64 + j), xa = *(const LAS f32x4*)(XA + t * 64 + j);
                aw[t] += xw[0] * wu[0] + xw[1] * wu[1] + xw[2] * wu[2] + xw[3] * wu[3];
                aa[t] += xa[0] * au[0] + xa[1] * au[1] + xa[2] * au[2] + xa[3] * au[3]; }
        }
        const float w0c = w0[tid], a0c = a0[tid];
        const float mur = mu[CO_R + tid], muk = mu[CO_K + tid], muv = mu[CO_V + tid], muz = mu[CO_Z + tid];
#pragma unroll 4
        for (int t = 0; t < 16; ++t) {
            const LAS bf16_t* pc = PC + (t + 1) * C_COLS; const LAS bf16_t* pp = PC + t * C_COLS;
            float c_, q_;
            c_ = bf2f(pc[CO_R + tid]); q_ = bf2f(pp[CO_R + tid]); const float r = c_ + mur * (q_ - c_);
            c_ = bf2f(pc[CO_K + tid]); q_ = bf2f(pp[CO_K + tid]); const float k = c_ + muk * (q_ - c_);
            c_ = bf2f(pc[CO_V + tid]); q_ = bf2f(pp[CO_V + tid]); const float v = c_ + muv * (q_ - c_);
            c_ = bf2f(pc[CO_Z + tid]); q_ = bf2f(pp[CO_Z + tid]); const float z = c_ + muz * (q_ - c_);
            const float e = sigmoidf_(w0c + aw[t]) * 0.60653066f;
            const float u = 1.f - __expf(-e);
            const float a = sigmoidf_(a0c + aa[t]);
            float kk = k * kkc;
            const float nrm = sqrtf(wave_sum_fast(kk * kk));
            kk = kk / fmaxf(nrm, 1e-12f);
            const float kt = k * (1.f + (a - 1.f) * kac);
            const float rk = wave_sum_fast(r * kt * rkc);
            const float zs = z * sigmoidf_(z);
            const size_t o = (size_t)(r0 + t) * 512 + tid;
            oR[o] = f2bf(r); oU[o] = f2bf(u); oK[o] = f2bf(kt); oV[o] = f2bf(v); oKK[o] = f2bf(kk); oKA[o] = f2bf(kk * a); oZS[o] = f2bf(zs); oBV[o] = f2bf(rk * v * zs);
        }
        __syncthreads();
    }
}

__device__ void rwkv_scan(const Params& p, int layer, int bseq, int head, int half, bool sample, LAS unsigned char* lds) {
    const int tid = fresh_tid(), row = tid >> 4, part = tid & 15;
    LAS float* LR = (LAS float*)lds;
    LAS float* LU = LR + 4096; LAS float* LK = LU + 4096; LAS float* LKK = LK + 4096; LAS float* LKA = LKK + 4096; LAS float* LV = LKA + 4096; LAS float* LY = LV + 4096;
    const int row_base = sample ? NP_ROWS + bseq * 64 : bseq * TP;
    const int T = sample ? 64 : TP;
    const int nch = (T + 63) / 64;
    const int vrow = half * 32 + row;
    f32x2 sA = (f32x2){0.f, 0.f}, sB = sA;
    if (sample) { const float* S = p.in[6] + ((((size_t)layer * 32 + bseq) * 8 + head) * 64) * 64;
        const f32x4 s = *(const f32x4*)(S + (unsigned)(vrow * 64 + part * 4)); sA = (f32x2){s[0], s[1]}; sB = (f32x2){s[2], s[3]}; }
    const int st = tid >> 3, sp = (tid & 7) * 8;
    const unsigned poff = (unsigned)(st * 512 + sp);
    u32x4 pf[6];
#define RW_PREFETCH(c) do { const int _t = (c) * 64 + st; if (_t < T) { const size_t _o = (size_t)(row_base + (c) * 64) * 512 + head * 64; \
        _Pragma("unroll") for (int _i = 0; _i < 6; ++_i) pf[_i] = *(const u32x4*)(rarr(p, _i) + _o + poff); } \
        else { _Pragma("unroll") for (int _i = 0; _i < 6; ++_i) pf[_i] = (u32x4){0u, 0u, 0u, 0u}; } } while (0)
    RW_PREFETCH(0);
    float* YR = (float*)(p.ws + WS_YRAW);
    for (int c = 0; c < nch; ++c) {
        const int L = (T - c * 64) < 64 ? (T - c * 64) : 64;
        {
            LAS float* dst[6] = {LR, LU, LK, LV, LKK, LKA};
#pragma unroll
            for (int i = 0; i < 6; ++i) { const u32x4 w = pf[i]; LAS float* d = dst[i] + st * 64 + sp;
                *(LAS f32x4*)d = (f32x4){bflo(w.x), bfhi(w.x), bflo(w.y), bfhi(w.y)}; *(LAS f32x4*)(d + 4) = (f32x4){bflo(w.z), bfhi(w.z), bflo(w.w), bfhi(w.w)}; }
        }
        __syncthreads();
        if (c + 1 < nch) RW_PREFETCH(c + 1);
        {
            const LAS float* qkk = LKK + part * 4; const LAS float* qu = LU + part * 4; const LAS float* qka = LKA + part * 4; const LAS float* qk = LK + part * 4; const LAS float* qr = LR + part * 4;
            const LAS float* qv = LV + vrow; LAS float* qy = LY + row;
            f32x4 kk = *(const LAS f32x4*)qkk, u = *(const LAS f32x4*)qu, ka = *(const LAS f32x4*)qka, k = *(const LAS f32x4*)qk, r = *(const LAS f32x4*)qr; float v = *qv;
#pragma unroll 2
            for (int t = 0; t < L; ++t) {
                const int tn = (t + 1 < 64 ? t + 1 : 63) * 64;
                const f32x4 nkk = *(const LAS f32x4*)(qkk + tn), nu = *(const LAS f32x4*)(qu + tn), nka = *(const LAS f32x4*)(qka + tn), nk = *(const LAS f32x4*)(qk + tn), nr = *(const LAS f32x4*)(qr + tn);
                const float nv = qv[tn];
                const f32x2 d2 = sA * (f32x2){kk[0], kk[1]} + sB * (f32x2){kk[2], kk[3]};
                const float sa = -row16_sum(d2[0] + d2[1]);
                const f32x2 sa2 = (f32x2){sa, sa}, v2 = (f32x2){v, v};
                sA = (sA - sA * (f32x2){u[0], u[1]}) + (sa2 * (f32x2){ka[0], ka[1]} + v2 * (f32x2){k[0], k[1]});
                sB = (sB - sB * (f32x2){u[2], u[3]}) + (sa2 * (f32x2){ka[2], ka[3]} + v2 * (f32x2){k[2], k[3]});
                const f32x2 y2 = sA * (f32x2){r[0], r[1]} + sB * (f32x2){r[2], r[3]};
                const float y = row16_sum(y2[0] + y2[1]);
                if (part == 0) qy[t * 32] = y;
                kk = nkk; u = nu; ka = nka; k = nk; r = nr; v = nv;
            }
        }
        __syncthreads();
        { const int t = tid >> 3, r4 = (tid & 7) * 4;
          if (t < L) *(f32x4*)(YR + (size_t)(row_base + c * 64) * 512 + head * 64 + half * 32 + (unsigned)(t * 512 + r4)) = *(const LAS f32x4*)(LY + t * 32 + r4); }
        __syncthreads();
    }
#undef RW_PREFETCH
    { float* So = p.out + (sample ? O_RS + ((((size_t)layer * 32 + bseq) * 8 + head) * 64) * 64 : O_RP + ((((size_t)layer * 8 + bseq) * 8 + head) * 64) * 64);
      *(f32x4*)(So + (unsigned)(vrow * 64 + part * 4)) = (f32x4){sA[0], sA[1], sB[0], sB[1]}; }
    __syncthreads();
}

__device__ void rwkv_post(const Params& p, int layer, int bid, int nb) {
    const int tid = fresh_tid(), lane = tid & 63, wid = tid >> 6;
    const float* YR = (const float*)(p.ws + WS_YRAW);
    const bf16_t* ZS = rarr(p, 6); const bf16_t* BV = rarr(p, 7);
    bf16_t* YC = (bf16_t*)(p.ws + WS_BUFB) + 1536;
    const float* gng = p.in[25] + layer * 512; const float* gnb = p.in[26] + layer * 512;
    const unsigned co = (unsigned)(lane * 8);
    const f32x4 g0 = *(const f32x4*)(gng + co), g1 = *(const f32x4*)(gng + co + 4), b0 = *(const f32x4*)(gnb + co), b1 = *(const f32x4*)(gnb + co + 4);
    const float gg[8] = {g0[0], g0[1], g0[2], g0[3], g1[0], g1[1], g1[2], g1[3]}, bb[8] = {b0[0], b0[1], b0[2], b0[3], b1[0], b1[1], b1[2], b1[3]};
    for (int r = bid * 8 + wid; r < MROWS; r += nb * 8) {
        const f32x4 ya = *(const f32x4*)(YR + (size_t)r * 512 + co), yb = *(const f32x4*)(YR + (size_t)r * 512 + co + 4);
        const u32x4 zs = *(const u32x4*)(ZS + (size_t)r * 512 + co), bv = *(const u32x4*)(BV + (size_t)r * 512 + co);
        float y[8] = {ya[0], ya[1], ya[2], ya[3], yb[0], yb[1], yb[2], yb[3]};
        float sm = 0.f;
#pragma unroll
        for (int j = 0; j < 8; ++j) sm += y[j];
        sm += dppf<0xB1>(sm); sm += dppf<0x4E>(sm); sm += dppf<0x141>(sm);
        const float mean = sm * (1.f / 64.f);
        float sv = 0.f;
#pragma unroll
        for (int j = 0; j < 8; ++j) { y[j] -= mean; sv += y[j] * y[j]; }
        sv += dppf<0xB1>(sv); sv += dppf<0x4E>(sv); sv += dppf<0x141>(sv);
        const float rstd = rsqrtf(sv * (1.f / 64.f) + 64e-5f);
        const float zz[8] = {bflo(zs.x), bfhi(zs.x), bflo(zs.y), bfhi(zs.y), bflo(zs.z), bfhi(zs.z), bflo(zs.w), bfhi(zs.w)};
        const float vv[8] = {bflo(bv.x), bfhi(bv.x), bflo(bv.y), bfhi(bv.y), bflo(bv.z), bfhi(bv.z), bflo(bv.w), bfhi(bv.w)};
        float o[8];
#pragma unroll
        for (int j = 0; j < 8; ++j) o[j] = (y[j] * rstd * gg[j] + bb[j]) * zz[j] + vv[j];
        u32x4 w; w.x = pk2(o[0], o[1]); w.y = pk2(o[2], o[3]); w.z = pk2(o[4], o[5]); w.w = pk2(o[6], o[7]);
        *(u32x4*)(YC + (size_t)r * 2048 + co) = w;
    }
}

constexpr int QS_LD = 136, VT_LD = 72, HO_LD = 132;
constexpr int L_QS = 0, L_KS = L_QS + 64 * QS_LD * 2, L_VT = L_KS + 64 * QS_LD * 2, L_KT = L_VT + 144 * VT_LD * 2, L_CB = L_KT + 128 * VT_LD * 2,
              L_SS = L_CB + 144 * QS_LD * 2, L_HO = L_SS + 64 * VT_LD * 2, L_GT = L_HO + 64 * HO_LD * 4, L_END = L_GT + 6144;
static_assert(L_END <= LDS_BYTES, "LDS overflow");
constexpr int G_B = 0, G_IG = 64, G_MT = 128, G_WI = 192, G_EMT = 256, G_WS = 320, G_DEN = 384, G_AMID = 448, G_AEND = 576, G_TOT = 704, G_LB = 1216, G_SC = 1344;

#define FRESH_IDS int T_ = threadIdx.x; asm volatile("" : "+v"(T_)); const int lane = T_ & 63; const int wid = __builtin_amdgcn_readfirstlane(T_ >> 6); \
    const int l15 = lane & 15, lq = lane >> 4, st = T_ >> 3, sp = (T_ & 7) * 16; (void)lane; (void)wid; (void)l15; (void)lq; (void)st; (void)sp;
template <int KIND>
__device__ void chunk_unit(const Params& p, int layer, int bseq, int head, bool sample, LAS unsigned char* lds) {
    constexpr int NVT = KIND == 0 ? 9 : 8;
    LAS bf16_t* QS = (LAS bf16_t*)(lds + L_QS); LAS bf16_t* KS = (LAS bf16_t*)(lds + L_KS); LAS bf16_t* VT = (LAS bf16_t*)(lds + L_VT);
    LAS bf16_t* KT = (LAS bf16_t*)(lds + L_KT); LAS bf16_t* CB = (LAS bf16_t*)(lds + L_CB); LAS bf16_t* SS = (LAS bf16_t*)(lds + L_SS);
    LAS float* HO = (LAS float*)(lds + L_HO); LAS float* GT = (LAS float*)(lds + L_GT);
    const bf16_t* P = (const bf16_t*)(p.ws + WS_P);
    const int cq = KIND == 0 ? A_Q + head * 128 : B_Q + head * 128;
    const int ck = KIND == 0 ? A_K + head * 128 : B_F + head * 128;
    const int cv = KIND == 0 ? A_V + head * 128 : B_I + head * 128;
    const int cz = KIND == 0 ? A_Z + head * 128 : B_Z + head * 128;
    const int co = A_O + head * 128;
    const int row_base = sample ? NP_ROWS + bseq * 64 : bseq * TP;
    const int nchunks = sample ? 1 : 33;
    const int NB = sample ? 32 : 8;

    f32x4 C[NVT];
#pragma unroll
    for (int vt = 0; vt < NVT; ++vt) C[vt] = (f32x4){0.f, 0.f, 0.f, 0.f};
    float m_run = 0.f;
    {
        FRESH_IDS
        if (sample) {
            if (KIND == 0) {
                const float* Cin = p.in[2] + ((((size_t)layer * 32 + bseq) * 8 + head) * 128) * 128;
#pragma unroll
                for (int vt = 0; vt < 8; ++vt)
#pragma unroll
                    for (int j = 0; j < 4; ++j) C[vt][j] = Cin[(unsigned)((vt * 16 + lq * 4 + j) * 128 + wid * 16 + l15)];
                if (lq == 0) C[NVT - 1][0] = (p.in[3] + (((size_t)layer * 32 + bseq) * 8 + head) * 128)[(unsigned)(wid * 16 + l15)];
                m_run = p.in[4][((size_t)layer * 32 + bseq) * 8 + head];
            } else {
                const float* Sin = p.in[5] + ((((size_t)layer * 32 + bseq) * 4 + head) * 128) * 128;
#pragma unroll
                for (int vt = 0; vt < 8; ++vt) C[vt] = *(const f32x4*)(Sin + (unsigned)((wid * 16 + l15) * 128 + vt * 16 + lq * 4));
            }
        }
        if (KIND == 0) { for (int i = T_; i < 16 * 64; i += NTHREADS) { const int rr = i >> 6, ss = i & 63; VT[(128 + rr) * VT_LD + ss] = rr == 0 ? (bf16_t)0x3F80 : (bf16_t)0; } }
        else if (T_ < 128) { float lb = 0.f; if (layer == 1) { const float l0 = p.in[15][head * 128 + T_], l1 = p.in[15][512 + head * 128 + T_]; lb = sigmoidf_(l1 - l0); } GT[G_LB + T_] = lb; }
    }
    const float b_i = KIND == 0 ? p.in[12][layer * 8 + head] : 0.f, b_f = KIND == 0 ? p.in[13][layer * 8 + head] : 0.f;

    u32x4 pq[2], pk[2], pv[2]; bf16_t pgi = 0, pgf = 0;
#define CU_PREFETCH(c) do { FRESH_IDS const int _t0 = sample ? 0 : ((c) == 0 ? 0 : 16 + 64 * ((c) - 1)); const int _L = (!sample && (c) == 0) ? 16 : 64; \
        const bf16_t* _r = P + (size_t)(row_base + _t0) * NINP; const unsigned toff = (unsigned)(st * NINP + sp); \
        if (st < _L) { \
            pq[0] = *(const u32x4*)(_r + cq + toff); pq[1] = *(const u32x4*)(_r + cq + 8 + toff); pk[0] = *(const u32x4*)(_r + ck + toff); pk[1] = *(const u32x4*)(_r + ck + 8 + toff); \
            pv[0] = *(const u32x4*)(_r + cv + toff); pv[1] = *(const u32x4*)(_r + cv + 8 + toff); } \
        else { pq[0] = pq[1] = pk[0] = pk[1] = pv[0] = pv[1] = (u32x4){0u, 0u, 0u, 0u}; } \
        if (KIND == 0 && T_ < 64) { if (T_ < _L) { const unsigned goff = (unsigned)(T_ * NINP); pgi = (_r + A_I + head)[goff]; pgf = (_r + A_F + head)[goff]; } } } while (0)
    CU_PREFETCH(0);
    if (KIND == 1) __syncthreads();

    for (int c = 0; c < nchunks; ++c) {
        const int t0 = sample ? 0 : (c == 0 ? 0 : 16 + 64 * (c - 1));
        const int L = (!sample && c == 0) ? 16 : 64;
        float qf[16], kf[16];
        {
            FRESH_IDS
            const unsigned qw[8] = {pq[0].x, pq[0].y, pq[0].z, pq[0].w, pq[1].x, pq[1].y, pq[1].z, pq[1].w};
            const unsigned kw[8] = {pk[0].x, pk[0].y, pk[0].z, pk[0].w, pk[1].x, pk[1].y, pk[1].z, pk[1].w};
            const unsigned vw[8] = {pv[0].x, pv[0].y, pv[0].z, pv[0].w, pv[1].x, pv[1].y, pv[1].z, pv[1].w};
            (void)qw;
            { LAS bf16_t* vtp = VT + sp * VT_LD + st;
#pragma unroll
              for (int j = 0; j < 8; ++j) { vtp[(2 * j) * VT_LD] = (bf16_t)(vw[j] & 0xffffu); vtp[(2 * j + 1) * VT_LD] = (bf16_t)(vw[j] >> 16); } }
            if (KIND == 0) {
                *(LAS u32x4*)(QS + st * QS_LD + sp) = pq[0]; *(LAS u32x4*)(QS + st * QS_LD + sp + 8) = pq[1];
                u32x4 k0, k1; const float sc = 0.08838834764831845f;
                k0.x = pk2(bflo(kw[0]) * sc, bfhi(kw[0]) * sc); k0.y = pk2(bflo(kw[1]) * sc, bfhi(kw[1]) * sc); k0.z = pk2(bflo(kw[2]) * sc, bfhi(kw[2]) * sc); k0.w = pk2(bflo(kw[3]) * sc, bfhi(kw[3]) * sc);
                k1.x = pk2(bflo(kw[4]) * sc, bfhi(kw[4]) * sc); k1.y = pk2(bflo(kw[5]) * sc, bfhi(kw[5]) * sc); k1.z = pk2(bflo(kw[6]) * sc, bfhi(kw[6]) * sc); k1.w = pk2(bflo(kw[7]) * sc, bfhi(kw[7]) * sc);
                *(LAS u32x4*)(KS + st * QS_LD + sp) = k0; *(LAS u32x4*)(KS + st * QS_LD + sp + 8) = k1;
                pk[0] = k0; pk[1] = k1;
                if (wid == 0) {
                    const float ig = lane < L ? bf2f(pgi) + b_i : -1e30f;
                    const float lf = lane < L ? logsigmoidf_(bf2f(pgf) + b_f) : 0.f;
                    float b = lf;
#pragma unroll
                    for (int d = 1; d < 64; d <<= 1) { const float y = __shfl_up(b, d); if (lane >= d) b += y; }
                    float pm = ig - b;
#pragma unroll
                    for (int d = 1; d < 64; d <<= 1) { const float y = __shfl_up(pm, d); if (lane >= d) pm = fmaxf(pm, y); }
                    const float b_end = __shfl(b, 63), pm_end = __shfl(pm, 63);
                    const float mt = b + fmaxf(m_run, pm);
                    const float m_new = b_end + fmaxf(m_run, pm_end);
                    GT[G_B + lane] = b; GT[G_IG + lane] = ig; GT[G_MT + lane] = mt; GT[G_WI + lane] = __expf(b + m_run - mt); GT[G_EMT + lane] = __expf(-mt);
                    GT[G_WS + lane] = __expf(b_end - b + ig - m_new);
                    if (lane == 0) { GT[G_SC + 0] = __expf(b_end + m_run - m_new); GT[G_SC + 1] = m_new; }
                }
                { LAS bf16_t* cbp = CB + (lq * 4) * QS_LD + wid * 16 + l15;
#pragma unroll
                  for (int vt = 0; vt < NVT; ++vt)
#pragma unroll
                    for (int j = 0; j < 4; ++j) cbp[(vt * 16 + j) * QS_LD] = f2bf(C[vt][j]); }
            } else {
#pragma unroll
                for (int j = 0; j < 8; ++j) {
#pragma unroll
                    for (int h = 0; h < 2; ++h) { const int e = 2 * j + h;
                        const float fp = h ? bfhi(kw[j]) : bflo(kw[j]); qf[e] = h ? bfhi(qw[j]) : bflo(qw[j]);
                        const float lb = GT[G_LB + sp + e]; const float sg = sigmoidf_(fp);
                        float lf = __logf(lb + (1.f - lb) * sg); float kk = (1.f - lb) * (1.f - sg);
                        if (st >= L) { lf = 0.f; kk = 0.f; }
                        kf[e] = kk; HO[st * HO_LD + sp + e] = lf; }
                }
            }
        }
        __syncthreads();
        float w_old = 1.f, m_new = 0.f;
        if (KIND == 0) {
            FRESH_IDS
            w_old = GT[G_SC + 0]; m_new = GT[G_SC + 1];
            const float wsv = GT[G_WS + st];
            const unsigned kw[8] = {pk[0].x, pk[0].y, pk[0].z, pk[0].w, pk[1].x, pk[1].y, pk[1].z, pk[1].w};
            LAS bf16_t* ktp = KT + sp * VT_LD + st;
#pragma unroll
            for (int j = 0; j < 8; ++j) { ktp[(2 * j) * VT_LD] = f2bf(bflo(kw[j]) * wsv); ktp[(2 * j + 1) * VT_LD] = f2bf(bfhi(kw[j]) * wsv); }
        } else {
            { FRESH_IDS const int k = T_ & 127, tg = T_ >> 7; float run = 0.f; LAS float* hp = HO + (tg * 16) * HO_LD + k;
#pragma unroll
              for (int i = 0; i < 16; ++i) { run += hp[i * HO_LD]; hp[i * HO_LD] = run; }
              GT[G_TOT + tg * 128 + k] = run; }
            __syncthreads();
            { FRESH_IDS const int k = T_ & 127, tg = T_ >> 7; float off = 0.f; LAS float* hp = HO + (tg * 16) * HO_LD + k;
              for (int g = 0; g < tg; ++g) off += GT[G_TOT + g * 128 + k];
              if (tg > 0) {
#pragma unroll
                  for (int i = 0; i < 16; ++i) hp[i * HO_LD] += off; }
              if (tg == 1) GT[G_AMID + k] = hp[15 * HO_LD];
              if (tg == 3) GT[G_AEND + k] = hp[15 * HO_LD]; }
            __syncthreads();
            {
                FRESH_IDS
                unsigned qa[8], kb[8];
                LAS bf16_t* ktp = KT + sp * VT_LD + st; LAS float* hp = HO + st * HO_LD + sp; LAS float* gm = GT + G_AMID + sp; LAS float* ge = GT + G_AEND + sp;
#pragma unroll
                for (int j = 0; j < 8; ++j) { float qv[2], kv[2];
#pragma unroll
                    for (int h = 0; h < 2; ++h) { const int e = 2 * j + h; const float a = hp[e], am = gm[e], ae = ge[e];
                        qv[h] = qf[e] * __expf(a - am); kv[h] = kf[e] * __expf(am - a);
                        ktp[e * VT_LD] = f2bf(kf[e] * __expf(ae - a)); }
                    qa[j] = pk2(qv[0], qv[1]); kb[j] = pk2(kv[0], kv[1]); }
                *(LAS u32x4*)(QS + st * QS_LD + sp) = (u32x4){qa[0], qa[1], qa[2], qa[3]}; *(LAS u32x4*)(QS + st * QS_LD + sp + 8) = (u32x4){qa[4], qa[5], qa[6], qa[7]};
                *(LAS u32x4*)(KS + st * QS_LD + sp) = (u32x4){kb[0], kb[1], kb[2], kb[3]}; *(LAS u32x4*)(KS + st * QS_LD + sp + 8) = (u32x4){kb[4], kb[5], kb[6], kb[7]};
                const float eam = __expf(GT[G_AMID + wid * 16 + l15]);
                LAS bf16_t* cbp = CB + (lq * 4) * QS_LD + wid * 16 + l15;
#pragma unroll
                for (int vt = 0; vt < NVT; ++vt)
#pragma unroll
                    for (int j = 0; j < 4; ++j) cbp[(vt * 16 + j) * QS_LD] = f2bf(C[vt][j] * eam);
            }
            __syncthreads();
        }
        if (c + 1 < nchunks) CU_PREFETCH(c + 1);
        {
            FRESH_IDS
            const int ti = wid >> 1;
#pragma unroll
            for (int sjj = 0; sjj < 2; ++sjj) {
                const int sj = 2 * (wid & 1) + sjj;
                f32x4 a = (f32x4){0.f, 0.f, 0.f, 0.f};
                const LAS bf16_t* qp = QS + (ti * 16 + l15) * QS_LD + lq * 8; const LAS bf16_t* kp = KS + (sj * 16 + l15) * QS_LD + lq * 8;
#pragma unroll
                for (int kk = 0; kk < 4; ++kk) { const bf16x8 fa = *(const LAS bf16x8*)(qp + kk * 32); const bf16x8 fb = *(const LAS bf16x8*)(kp + kk * 32);
                    a = __builtin_amdgcn_mfma_f32_16x16x32_bf16(fa, fb, a, 0, 0, 0); }
                const int s = sj * 16 + l15;
                const float cs_ = KIND == 0 ? GT[G_IG + s] - GT[G_B + s] : 0.f;
                LAS bf16_t* ssp = SS + (ti * 16 + lq * 4) * VT_LD + s;
#pragma unroll
                for (int j = 0; j < 4; ++j) { const int t = ti * 16 + lq * 4 + j; float val;
                    if (KIND == 0) { const float arg = s <= t ? (GT[G_B + t] - GT[G_MT + t]) + cs_ : -1e30f; val = a[j] * __expf(arg); } else val = s <= t ? a[j] : 0.f;
                    ssp[j * VT_LD] = f2bf(val); }
            }
        }
        f32x4 hacc[5];
#pragma unroll
        for (int i = 0; i < 5; ++i) hacc[i] = (f32x4){0.f, 0.f, 0.f, 0.f};
        {
            FRESH_IDS
            const int hti = wid & 3, hv0 = (wid >> 2) * 4;
            const LAS bf16_t* qp = QS + (hti * 16 + l15) * QS_LD + lq * 8; const LAS bf16_t* cp = CB + (hv0 * 16 + l15) * QS_LD + lq * 8; const LAS bf16_t* cn = CB + (128 + l15) * QS_LD + lq * 8;
#pragma unroll
            for (int kk = 0; kk < 4; ++kk) {
                const bf16x8 fa = *(const LAS bf16x8*)(qp + kk * 32);
#pragma unroll
                for (int i = 0; i < 4; ++i) { const bf16x8 fb = *(const LAS bf16x8*)(cp + i * 16 * QS_LD + kk * 32); hacc[i] = __builtin_amdgcn_mfma_f32_16x16x32_bf16(fa, fb, hacc[i], 0, 0, 0); }
                if (KIND == 0 && wid < 4) { const bf16x8 fb = *(const LAS bf16x8*)(cn + kk * 32); hacc[4] = __builtin_amdgcn_mfma_f32_16x16x32_bf16(fa, fb, hacc[4], 0, 0, 0); }
                __builtin_amdgcn_sched_barrier(0);
            }
            if (KIND == 0) {
#pragma unroll
                for (int j = 0; j < 4; ++j) { const float wi = GT[G_WI + hti * 16 + lq * 4 + j];
#pragma unroll
                    for (int i = 0; i < 5; ++i) hacc[i][j] *= wi; }
            }
        }
        __syncthreads();
        u32x4 pz[2], po[2];
        {
            FRESH_IDS
            const int hti = wid & 3, hv0 = (wid >> 2) * 4;
            const LAS bf16_t* sp_ = SS + (hti * 16 + l15) * VT_LD + lq * 8; const LAS bf16_t* vp = VT + (hv0 * 16 + l15) * VT_LD + lq * 8; const LAS bf16_t* vn = VT + (128 + l15) * VT_LD + lq * 8;
#pragma unroll
            for (int kk = 0; kk < 2; ++kk) {
                const bf16x8 fa = *(const LAS bf16x8*)(sp_ + kk * 32);
#pragma unroll
                for (int i = 0; i < 4; ++i) { const bf16x8 fb = *(const LAS bf16x8*)(vp + i * 16 * VT_LD + kk * 32); hacc[i] = __builtin_amdgcn_mfma_f32_16x16x32_bf16(fa, fb, hacc[i], 0, 0, 0); }
                if (KIND == 0 && wid < 4) { const bf16x8 fb = *(const LAS bf16x8*)(vn + kk * 32); hacc[4] = __builtin_amdgcn_mfma_f32_16x16x32_bf16(fa, fb, hacc[4], 0, 0, 0); }
                __builtin_amdgcn_sched_barrier(0);
            }
            { const bf16_t* r_ = P + (size_t)(row_base + t0) * NINP; const unsigned zo = st < L ? (unsigned)(st * NINP + sp) : (unsigned)sp;
              pz[0] = *(const u32x4*)(r_ + cz + zo); pz[1] = *(const u32x4*)(r_ + cz + 8 + zo);
              if (KIND == 0) { po[0] = *(const u32x4*)(r_ + co + zo); po[1] = *(const u32x4*)(r_ + co + 8 + zo); } }
            if (KIND == 0) {
                if (wid < 4 && l15 == 0) {
#pragma unroll
                    for (int j = 0; j < 4; ++j) GT[G_DEN + hti * 16 + lq * 4 + j] = hacc[4][j]; }
                __syncthreads();
                LAS float* hp = HO + (hti * 16 + lq * 4) * HO_LD + hv0 * 16 + l15;
#pragma unroll
                for (int j = 0; j < 4; ++j) { const int t = hti * 16 + lq * 4 + j; const float dn = __builtin_amdgcn_rcpf(fmaxf(fabsf(GT[G_DEN + t]), GT[G_EMT + t]));
#pragma unroll
                    for (int i = 0; i < 4; ++i) hp[j * HO_LD + i * 16] = hacc[i][j] * dn; }
            } else {
                LAS float* hp = HO + (hti * 16 + lq * 4) * HO_LD + hv0 * 16 + l15;
#pragma unroll
                for (int j = 0; j < 4; ++j) {
#pragma unroll
                    for (int i = 0; i < 4; ++i) hp[j * HO_LD + i * 16] = hacc[i][j]; }
            }
        }
        __syncthreads();
        {
            FRESH_IDS
            float hv[16];
#pragma unroll
            for (int q = 0; q < 4; ++q) { const f32x4 x = *(const LAS f32x4*)(HO + st * HO_LD + sp + q * 4); hv[q * 4] = x[0]; hv[q * 4 + 1] = x[1]; hv[q * 4 + 2] = x[2]; hv[q * 4 + 3] = x[3]; }
            float rs;
            if (KIND == 0) {
                float sm = 0.f;
#pragma unroll
                for (int j = 0; j < 16; ++j) sm += hv[j];
                sm += __shfl_xor(sm, 1); sm += __shfl_xor(sm, 2); sm += __shfl_xor(sm, 4);
                const float mean = sm * (1.f / 128.f); float sv = 0.f;
#pragma unroll
                for (int j = 0; j < 16; ++j) { hv[j] -= mean; sv += hv[j] * hv[j]; }
                sv += __shfl_xor(sv, 1); sv += __shfl_xor(sv, 2); sv += __shfl_xor(sv, 4);
                rs = rsqrtf(sv * (1.f / 128.f) + 1e-6f);
            } else {
                float sv = 0.f;
#pragma unroll
                for (int j = 0; j < 16; ++j) sv += hv[j] * hv[j];
                sv += __shfl_xor(sv, 1); sv += __shfl_xor(sv, 2); sv += __shfl_xor(sv, 4);
                rs = rsqrtf(sv * (1.f / 128.f) + 1e-6f);
            }
            const float* nwb = (KIND == 0 ? p.in[14] + layer * 1024 : p.in[16] + layer * 512) + head * 128; float nw[16];
#pragma unroll
            for (int q = 0; q < 4; ++q) { const f32x4 x = *(const f32x4*)(nwb + (unsigned)(sp + q * 4)); nw[q * 4] = x[0]; nw[q * 4 + 1] = x[1]; nw[q * 4 + 2] = x[2]; nw[q * 4 + 3] = x[3]; }
            const unsigned zw[8] = {pz[0].x, pz[0].y, pz[0].z, pz[0].w, pz[1].x, pz[1].y, pz[1].z, pz[1].w};
            unsigned ow[8] = {0, 0, 0, 0, 0, 0, 0, 0};
            if (KIND == 0) { ow[0] = po[0].x; ow[1] = po[0].y; ow[2] = po[0].z; ow[3] = po[0].w; ow[4] = po[1].x; ow[5] = po[1].y; ow[6] = po[1].z; ow[7] = po[1].w; }
            unsigned res[8];
#pragma unroll
            for (int j = 0; j < 8; ++j) { float o2[2];
#pragma unroll
                for (int h = 0; h < 2; ++h) { const int e = 2 * j + h; const float z = h ? bfhi(zw[j]) : bflo(zw[j]);
                    float o = hv[e] * rs * nw[e] * (z * sigmoidf_(z));
                    if (KIND == 0) { const float og = h ? bfhi(ow[j]) : bflo(ow[j]); o *= sigmoidf_(og); }
                    o2[h] = o; }
                res[j] = pk2(o2[0], o2[1]); }
            if (st < L) {
                bf16_t* Yb = (bf16_t*)(p.ws + WS_BUFB) + (size_t)(row_base + t0) * 2048 + (KIND == 0 ? 0 : 1024) + head * 128;
                const unsigned yo = (unsigned)(st * 2048 + sp);
                *(u32x4*)(Yb + yo) = (u32x4){res[0], res[1], res[2], res[3]}; *(u32x4*)(Yb + 8 + yo) = (u32x4){res[4], res[5], res[6], res[7]};
            }
        }
        {
            FRESH_IDS
            float csc = w_old;
            if (KIND == 1) csc = __expf(GT[G_AEND + wid * 16 + l15]);
#pragma unroll
            for (int vt = 0; vt < NVT; ++vt) C[vt] *= csc;
            const LAS bf16_t* kp = KT + (wid * 16 + l15) * VT_LD + lq * 8; const LAS bf16_t* vp = VT + l15 * VT_LD + lq * 8;
#pragma unroll
            for (int kk = 0; kk < 2; ++kk) {
                const bf16x8 fb = *(const LAS bf16x8*)(kp + kk * 32);
#pragma unroll
                for (int vt = 0; vt < NVT; ++vt) { const bf16x8 fa = *(const LAS bf16x8*)(vp + vt * 16 * VT_LD + kk * 32); C[vt] = __builtin_amdgcn_mfma_f32_16x16x32_bf16(fa, fb, C[vt], 0, 0, 0); }
                __builtin_amdgcn_sched_barrier(0);
            }
            m_run = m_new;
        }
        __syncthreads();
    }
#undef CU_PREFETCH
    {
        FRESH_IDS
        if (KIND == 0) {
            float* Co = p.out + (sample ? O_CS : O_CP) + ((((size_t)layer * NB + bseq) * 8 + head) * 128) * 128;
#pragma unroll
            for (int vt = 0; vt < 8; ++vt)
#pragma unroll
                for (int j = 0; j < 4; ++j) Co[(unsigned)((vt * 16 + lq * 4 + j) * 128 + wid * 16 + l15)] = C[vt][j];
            if (lq == 0) (p.out + (sample ? O_NS : O_NP) + (((size_t)layer * NB + bseq) * 8 + head) * 128)[(unsigned)(wid * 16 + l15)] = C[NVT - 1][0];
            if (T_ == 0) p.out[(sample ? O_MS : O_MP) + ((size_t)layer * NB + bseq) * 8 + head] = m_run;
        } else {
            float* So = p.out + (sample ? O_HS : O_HP) + ((((size_t)layer * NB + bseq) * 4 + head) * 128) * 128;
#pragma unroll
            for (int vt = 0; vt < 8; ++vt) *(f32x4*)(So + (unsigned)((wid * 16 + l15) * 128 + vt * 16 + lq * 4)) = C[vt];
        }
    }
    __syncthreads();
}

__device__ void mixer_unit(const Params& p, int layer, int kind, int v, bool sample, LAS unsigned char* lds) {
    if (kind == 0) rwkv_scan(p, layer, v >> 4, (v >> 1) & 7, v & 1, sample, lds);
    if (kind == 1) chunk_unit<0>(p, layer, v >> 3, v & 7, sample, lds);
    if (kind == 2) chunk_unit<1>(p, layer, v >> 2, v & 3, sample, lds);
}
__device__ void mixer_phase(const Params& p, int layer, LAS unsigned char* lds, int bid, int nb) {
    constexpr int NLONG = 224, NSMALL = 896;
    if (nb >= NLONG + 8) {
        if (bid < NLONG) { if (bid < 128) mixer_unit(p, layer, 0, bid, false, lds); else if (bid < 192) mixer_unit(p, layer, 1, bid - 128, false, lds); else mixer_unit(p, layer, 2, bid - 192, false, lds); }
        unsigned* ctr = (unsigned*)(p.ws + WS_CTR) + layer;
        LAS unsigned* slot = (LAS unsigned*)(lds + LDS_BYTES - 16);
        for (;;) {
            __syncthreads();
            if (fresh_tid() == 0) *slot = atomicAdd(ctr, 1u);
            __syncthreads();
            const unsigned u = *slot;
            if (u >= (unsigned)NSMALL) break;
            if (u < 256) mixer_unit(p, layer, 1, (int)u, true, lds); else if (u < 384) mixer_unit(p, layer, 2, (int)u - 256, true, lds); else mixer_unit(p, layer, 0, (int)u - 384, true, lds);
        }
    } else {
        for (int u = bid; u < NLONG + NSMALL; u += nb) {
            if (u < 128) mixer_unit(p, layer, 0, u, false, lds); else if (u < 192) mixer_unit(p, layer, 1, u - 128, false, lds); else if (u < 224) mixer_unit(p, layer, 2, u - 192, false, lds);
            else if (u < 480) mixer_unit(p, layer, 1, u - 224, true, lds); else if (u < 608) mixer_unit(p, layer, 2, u - 480, true, lds); else mixer_unit(p, layer, 0, u - 608, true, lds);
        }
    }
}

__global__ void __launch_bounds__(NTHREADS, 2) fwd_kernel(Params p) {
    extern __shared__ __attribute__((aligned(16))) unsigned char shm_[];
    LAS unsigned char* lds = (LAS unsigned char*)shm_;
    const int nb = gridDim.x;
    bf16_t* WTIN = (bf16_t*)(p.ws + WS_WTIN);
    bf16_t* BUFA = (bf16_t*)(p.ws + WS_BUFA); bf16_t* BUFB = (bf16_t*)(p.ws + WS_BUFB); bf16_t* PB = (bf16_t*)(p.ws + WS_P);
#ifndef PROBE_SUB
#define PROBE_SUB -1
#endif
    for (int ph = p.ph_lo; ph < p.ph_hi; ++ph) {
      const int nrep = (PROBE_SUB >= 0 && ((ph == 0 && PROBE_SUB == 7) || (ph > 0 && (ph - 1) % 7 == PROBE_SUB))) ? 2 : 1;
#pragma unroll 1
      for (int rep = 0; rep < nrep; ++rep) {
        int bid = blockIdx.x; asm volatile("" : "+s"(bid));
        if (ph == 0) {
#ifndef SKIP_CONV
            convert_T(p.in[11], 2048, NIN, NINP, WTIN, 2048, (LAS float*)lds, bid, nb);
            for (int l = 0; l < 2; ++l) {
                bf16_t* wl = (bf16_t*)(p.ws + WS_WTS + (size_t)l * WTS_LAYER);
                convert_T(p.in[27] + (size_t)l * 1024 * 2048, 1024, 2048, 2048, wl, 2048, (LAS float*)lds, bid, nb);
                convert_T(p.in[28] + (size_t)l * 512 * 2048, 512, 2048, 2048, wl + 1024, 2048, (LAS float*)lds, bid, nb);
                convert_T(p.in[29] + (size_t)l * 512 * 2048, 512, 2048, 2048, wl + 1536, 2048, (LAS float*)lds, bid, nb);
                convert_T(p.in[30] + (size_t)l * 2048 * 2048, 2048, 2048, 2048, wl + (size_t)2048 * 2048, 2048, (LAS float*)lds, bid, nb);
            }
#endif
#ifndef SKIP_NORM
            prenorm0(p, bid, nb);
#endif
        } else {
            const int layer = (ph - 1) / 7, sub = (ph - 1) % 7;
            bf16_t* wl = (bf16_t*)(p.ws + WS_WTS + (size_t)layer * WTS_LAYER);
            if (sub == 0) {
                pg8::Gemm g{BUFA, WTIN, MPAD, NINP, 2048}; pg8::StaticOrder S; S.init(MPAD, NINP, nb, bid);
                pg8::EpiStoreT<true> E{PB, NINP};
                pg8::gemm_phase(lds, g, S, E);
            } else if (sub == 1) {
#ifndef SKIP_PREP
                rwkv_prep(p, layer, lds, bid, nb);
#endif
            } else if (sub == 2) {
#ifndef SKIP_MIX
                mixer_phase(p, layer, lds, bid, nb);
#endif
            } else if (sub == 3) {
                rwkv_post(p, layer, bid, nb);
            } else if (sub == 4) {
                pg8::Gemm g{BUFB, wl, MPAD, 2048, 2048}; pg8::StaticOrder S; S.init(MPAD, 2048, nb, bid);
                pg8::EpiGate3 E{BUFA, PB + G_BASE};
                pg8::gemm_phase(lds, g, S, E);
            } else if (sub == 5) {
                pg8::Gemm g{BUFA, wl + (size_t)2048 * 2048, MPAD, 2048, 2048}; pg8::StaticOrder S; S.init(MPAD, 2048, nb, bid);
                pg8::EpiStoreT<false> E{BUFB, 2048};
                pg8::gemm_phase(lds, g, S, E);
            } else {
#ifndef SKIP_CONV
                if (layer == 0) convert_T(p.in[11] + (size_t)2048 * NIN, 2048, NIN, NINP, WTIN, 2048, (LAS float*)lds, bid, nb);
#endif
#ifndef SKIP_NORM
                postnorm(p, layer, bid, nb);
#endif
            }
        }
        if (ph + 1 < p.ph_hi || rep + 1 < nrep) { if (p.coop) cg::this_grid().sync(); }
      }
    }
}

extern "C" void kernel_launch(void* const* d_in, const int* in_sizes, int n_in, void* d_out, int out_size, void* d_ws, size_t ws_size, hipStream_t stream) {
    static int grid = 0;
    if (grid == 0) {
        if (n_in != 31 || ws_size < WS_END || (size_t)out_size != O_END) { fprintf(stderr, "kernel_launch: unexpected shapes: n_in %d out %d ws %zu (need %zu)\n", n_in, out_size, ws_size, (size_t)WS_END); grid = -1; return; }
        int dev = 0, cus = 0, per_cu = 0;
        hipGetDevice(&dev); hipDeviceGetAttribute(&cus, hipDeviceAttributeMultiprocessorCount, dev);
        if (hipFuncSetAttribute((const void*)fwd_kernel, hipFuncAttributeMaxDynamicSharedMemorySize, LDS_BYTES) != hipSuccess) { fprintf(stderr, "kernel_launch: hipFuncSetAttribute failed\n"); grid = -1; return; }
        if (hipOccupancyMaxActiveBlocksPerMultiprocessor(&per_cu, (const void*)fwd_kernel, NTHREADS, LDS_BYTES) != hipSuccess || per_cu < 1) { fprintf(stderr, "kernel_launch: occupancy query says %d\n", per_cu); per_cu = 1; }
        (void)hipGetLastError();
        grid = cus * per_cu;
    }
    if (grid < 0) return;
    if (hipMemsetAsync((char*)d_ws + WS_CTR, 0, 256, stream) != hipSuccess) { fprintf(stderr, "kernel_launch: memset failed\n"); return; }
    Params p{};
    for (int i = 0; i < 31; ++i) p.in[i] = (const float*)d_in[i];
    p.out = (float*)d_out; p.ws = (unsigned char*)d_ws; p.pad = 0;
#ifdef MULTI_LAUNCH
    p.coop = 0;
    for (int ph = 0; ph < 15; ++ph) { p.ph_lo = ph; p.ph_hi = ph + 1; hipLaunchKernelGGL(fwd_kernel, dim3(grid), dim3(NTHREADS), LDS_BYTES, stream, p); }
#else
    p.coop = 1; p.ph_lo = 0; p.ph_hi = 15;
    void* args[] = {&p};
    hipError_t e = hipLaunchCooperativeKernel((const void*)fwd_kernel, dim3(grid), dim3(NTHREADS), args, LDS_BYTES, stream);
    if (e != hipSuccess) fprintf(stderr, "cooperative launch failed: %s (grid %d)\n", hipGetErrorString(e), grid);
#endif
}
```

```cpp
#include <hip/hip_runtime.h>
#include <hip/hip_cooperative_groups.h>
#include <cstdio>
namespace cg = cooperative_groups;

#define LAS __attribute__((address_space(3)))
typedef unsigned short bf16_t;
typedef short bf16x8 __attribute__((ext_vector_type(8)));
typedef float f32x4 __attribute__((ext_vector_type(4)));
typedef float f32x2 __attribute__((ext_vector_type(2)));
typedef unsigned u32x4 __attribute__((ext_vector_type(4)));
typedef unsigned u32x2 __attribute__((ext_vector_type(2)));

constexpr int DM = 2048, MROWS = 18560, MPAD = 18688, NP_ROWS = 16512, TP = 2064;
constexpr int NIN = 15504, NINP = 15616;
constexpr int A_Q = 0, A_K = 1024, A_V = 2048, A_I = 3072, A_F = 3080, A_O = 3088, A_Z = 4112;
constexpr int B_Q = 5136, B_F = 5648, B_I = 6160, B_Z = 6672;
constexpr int C_BASE = 7184, C_COLS = 2176;
constexpr int CO_R = 0, CO_K = 512, CO_V = 1024, CO_WD = 1536, CO_AD = 1600, CO_Z = 1664;
constexpr int G_BASE = 9360;
constexpr int LDS_BYTES = 163840;
constexpr int NTHREADS = 512;

constexpr size_t O_YP = 0, O_YS = 33554432, O_CP = O_YS + 4194304, O_NP = O_CP + 2097152, O_MP = O_NP + 16384, O_HP = O_MP + 128,
                 O_RP = O_HP + 1048576, O_SHP = O_RP + 524288, O_CS = O_SHP + 34816, O_NS = O_CS + 8388608, O_MS = O_NS + 65536,
                 O_HS = O_MS + 512, O_RS = O_HS + 4194304, O_SHS = O_RS + 2097152, O_END = O_SHS + 139264;

constexpr size_t WS_WTIN = 0;
constexpr size_t WS_WTS = WS_WTIN + (size_t)NINP * 2048 * 2;
constexpr size_t WTS_LAYER = (size_t)2048 * 4096 * 2;
constexpr size_t WS_BUFA = WS_WTS + 2 * WTS_LAYER;
constexpr size_t BUF_BYTES = (size_t)MPAD * 2048 * 2;
constexpr size_t WS_BUFB = WS_BUFA + BUF_BYTES;
constexpr size_t WS_P = WS_BUFB + BUF_BYTES;
constexpr size_t WS_RX = WS_P + (size_t)MPAD * NINP * 2;
constexpr size_t RARR = (size_t)MPAD * 512 * 2;
constexpr size_t WS_XMETA = WS_RX + 4 * RARR;
constexpr size_t WS_YRAW = WS_XMETA + (size_t)8 * 16 * 2048 * 4;
constexpr size_t WS_CTR = WS_YRAW + (size_t)MPAD * 512 * 4;
constexpr size_t WS_END = WS_CTR + 256;

struct Params {
    const float* in[31];
    float* out;
    unsigned char* ws;
    int ph_lo, ph_hi, coop, pad;
};

__device__ __forceinline__ float bf2f(bf16_t x) { return __uint_as_float(((unsigned)x) << 16); }
__device__ __forceinline__ float bflo(unsigned w) { return __uint_as_float(w << 16); }
__device__ __forceinline__ float bfhi(unsigned w) { return __uint_as_float(w & 0xffff0000u); }
__device__ __forceinline__ bf16_t f2bf(float f) { unsigned u = __float_as_uint(f); u += 0x7FFFu + ((u >> 16) & 1u); return (bf16_t)(u >> 16); }
__device__ __forceinline__ unsigned pk2(float lo, float hi) { return (unsigned)f2bf(lo) | ((unsigned)f2bf(hi) << 16); }
__device__ __forceinline__ float sigmoidf_(float x) { return __builtin_amdgcn_rcpf(1.0f + __expf(-x)); }
__device__ __forceinline__ float logsigmoidf_(float x) { return fminf(x, 0.f) - __logf(1.0f + __expf(-fabsf(x))); }
__device__ __forceinline__ float wave_sum(float v) {
#pragma unroll
    for (int d = 32; d >= 1; d >>= 1) v += __shfl_xor(v, d);
    return v;
}
template <int CTRL> __device__ __forceinline__ float dppf(float v) { return __int_as_float(__builtin_amdgcn_update_dpp(0, __float_as_int(v), CTRL, 0xf, 0xf, true)); }
__device__ __forceinline__ float row16_sum(float v) {
    v += dppf<0xB1>(v); v += dppf<0x4E>(v); v += dppf<0x141>(v); v += dppf<0x140>(v); return v;
}

__device__ __forceinline__ int fresh_tid() { int t = threadIdx.x; asm volatile("" : "+v"(t)); return t; }
__device__ __forceinline__ float wave_sum_fast(float v) {
    v = row16_sum(v); const int iv = __float_as_int(v);
    return (__int_as_float(__builtin_amdgcn_readlane(iv, 0)) + __int_as_float(__builtin_amdgcn_readlane(iv, 16))) + (__int_as_float(__builtin_amdgcn_readlane(iv, 32)) + __int_as_float(__builtin_amdgcn_readlane(iv, 48)));
}
__device__ __forceinline__ const float* x0_row(const Params& p, int r) {
    if (r < NP_ROWS) { const int b = r / TP, t = r - b * TP; return t < 16 ? p.in[8] + (size_t)t * DM : p.in[0] + ((size_t)b * 2048 + (t - 16)) * DM; }
    return p.in[1] + (size_t)(r - NP_ROWS) * DM;
}
__device__ __forceinline__ float* x1_row(const Params& p, int r) {
    if (r < NP_ROWS) { const int b = r / TP, t = r - b * TP; return t < 16 ? (float*)(p.ws + WS_XMETA) + ((size_t)b * 16 + t) * DM : p.out + O_YP + ((size_t)b * 2048 + (t - 16)) * DM; }
    return p.out + O_YS + (size_t)(r - NP_ROWS) * DM;
}

namespace pg8 {
constexpr int BM = 256, BK = 64, HALF = 128, HTB = HALF * BK * 2, STAGE_BYTES = 8 * HTB, NXCD = 8, WGM = 8;
__device__ __forceinline__ int lds_byte(int r, int c) { const int st = (r >> 4) * 2 + (c >> 5), rr = r & 15, cc = c & 31, ob = rr * 64 + cc * 2; return st * 1024 + (ob ^ (((ob >> 9) & 1) << 5)); }
__device__ __forceinline__ void stage_rc(int b, int& R, int& C) { const int st = b / 1024, sb = b % 1024, swz = sb ^ (((sb >> 9) & 1) << 5); R = (st >> 1) * 16 + swz / 64; C = (st & 1) * 32 + (swz % 64) / 2; }
__device__ __forceinline__ int perm32(int rho) { const int n = rho >> 4, i = rho & 15; return 8 * (i >> 2) + 4 * n + (i & 3); }
struct Unit { int pm, pn; };
struct Gemm { const bf16_t* A; const bf16_t* Bt; int M, N, K; };
struct StaticOrder {
    int nM, nN, nwg, G, c;
    __device__ void init(int M, int N, int G_, int c_) { nM = M / BM; nN = N / BM; nwg = nM * nN; G = G_; c = c_; }
    __device__ bool next(int i, Unit& u) const {
        const long L = (long)i * G + c; if (L >= nwg) return false;
        int wgid = (int)L; { const int q = nwg / NXCD, r = nwg % NXCD, xcd = wgid % NXCD, off = wgid / NXCD; wgid = (xcd < r ? xcd * (q + 1) : r * (q + 1) + (xcd - r) * q) + off; }
        const int nig = WGM * nN, gid = wgid / nig, fm = gid * WGM, gsz = (nM - fm) < WGM ? (nM - fm) : WGM;
        u.pm = fm + ((wgid % nig) % gsz); u.pn = (wgid % nig) / gsz; return true;
    }
    __device__ __forceinline__ void a_ready(const Unit&) const {}
    __device__ __forceinline__ void done(const Unit&) const {}
};
__device__ __forceinline__ unsigned cvt_pk_bf16(float lo, float hi) { unsigned r; asm volatile("v_cvt_pk_bf16_f32 %0, %1, %2" : "=v"(r) : "v"(lo), "v"(hi)); return r; }

template <bool SIG> struct EpiStoreT {
    static constexpr bool PERM = true, HOOK = false;
    bf16_t* O; int ldc;
    __device__ __forceinline__ void mid(f32x4 (&acc)[2][2][4][2], const Unit& u, int wr, int wc, int fr, int fq, int which) const {}
    __device__ __forceinline__ void operator()(f32x4 (&acc)[2][2][4][2], const Unit& u, int wr, int wc, int fr, int fq) const {
        const int row0 = u.pm * BM + wr * 64 + fr, col0 = u.pn * BM + wc * 32 + 8 * fq;
#pragma unroll
        for (int bj = 0; bj < 2; ++bj) {
            const bool sg = SIG && (col0 + bj * HALF >= G_BASE);
#pragma unroll
            for (int ai = 0; ai < 2; ++ai)
#pragma unroll
                for (int m = 0; m < 4; ++m) { bf16_t* rowp = O + (size_t)(row0 + ai * HALF + m * 16) * ldc + col0;
                    f32x4 v0 = acc[ai][bj][m][0], v1 = acc[ai][bj][m][1];
                    if (sg) {
#pragma unroll
                        for (int j = 0; j < 4; ++j) { v0[j] = sigmoidf_(v0[j]); v1[j] = sigmoidf_(v1[j]); } }
                    u32x4 w; w.x = cvt_pk_bf16(v0[0], v0[1]); w.y = cvt_pk_bf16(v0[2], v0[3]); w.z = cvt_pk_bf16(v1[0], v1[1]); w.w = cvt_pk_bf16(v1[2], v1[3]);
                    *(u32x4*)(rowp + bj * HALF) = w; }
        }
    }
};
struct EpiGate3 {
    static constexpr bool PERM = true, HOOK = true;
    bf16_t* O; const bf16_t* SG;
    __device__ __forceinline__ void mid(f32x4 (&acc)[2][2][4][2], const Unit& u, int wr, int wc, int fr, int fq, int which) const {
        const int row0 = u.pm * BM + wr * 64 + fr, col0 = u.pn * BM + wc * 32 + 8 * fq;
        const bf16_t* gn = SG + which * 2048; const bf16_t* gd = SG + (which + 1) * 2048;
#pragma unroll
        for (int ai = 0; ai < 2; ++ai)
#pragma unroll
            for (int m = 0; m < 4; ++m) { const unsigned ro = (unsigned)(row0 + ai * HALF + m * 16) * (unsigned)NINP + (unsigned)col0;
#pragma unroll
                for (int bj = 0; bj < 2; ++bj) {
                    const u32x4 a = *(const u32x4*)(gn + ro + bj * HALF), b = *(const u32x4*)(gd + ro + bj * HALF);
                    f32x4& v0 = acc[ai][bj][m][0]; f32x4& v1 = acc[ai][bj][m][1];
                    v0[0] *= bflo(a.x) * __builtin_amdgcn_rcpf(bflo(b.x)); v0[1] *= bfhi(a.x) * __builtin_amdgcn_rcpf(bfhi(b.x));
                    v0[2] *= bflo(a.y) * __builtin_amdgcn_rcpf(bflo(b.y)); v0[3] *= bfhi(a.y) * __builtin_amdgcn_rcpf(bfhi(b.y));
                    v1[0] *= bflo(a.z) * __builtin_amdgcn_rcpf(bflo(b.z)); v1[1] *= bfhi(a.z) * __builtin_amdgcn_rcpf(bfhi(b.z));
                    v1[2] *= bflo(a.w) * __builtin_amdgcn_rcpf(bflo(b.w)); v1[3] *= bfhi(a.w) * __builtin_amdgcn_rcpf(bfhi(b.w));
                    asm volatile("" ::: "memory"); } }
    }
    __device__ __forceinline__ void operator()(f32x4 (&acc)[2][2][4][2], const Unit& u, int wr, int wc, int fr, int fq) const {
        const int row0 = u.pm * BM + wr * 64 + fr, col0 = u.pn * BM + wc * 32 + 8 * fq;
        const bf16_t* gc = SG + 4096;
#pragma unroll
        for (int ai = 0; ai < 2; ++ai)
#pragma unroll
            for (int m = 0; m < 4; ++m) { const unsigned rr = (unsigned)(row0 + ai * HALF + m * 16);
#pragma unroll
                for (int bj = 0; bj < 2; ++bj) { const f32x4 v0 = acc[ai][bj][m][0], v1 = acc[ai][bj][m][1];
                    const u32x4 g = *(const u32x4*)(gc + rr * (unsigned)NINP + col0 + bj * HALF);
                    u32x4 w; w.x = cvt_pk_bf16(v0[0] * bflo(g.x), v0[1] * bfhi(g.x)); w.y = cvt_pk_bf16(v0[2] * bflo(g.y), v0[3] * bfhi(g.y));
                    w.z = cvt_pk_bf16(v1[0] * bflo(g.z), v1[1] * bfhi(g.z)); w.w = cvt_pk_bf16(v1[2] * bflo(g.w), v1[3] * bfhi(g.w));
                    *(u32x4*)(O + rr * (unsigned)DM + col0 + bj * HALF) = w; asm volatile("" ::: "memory"); } }
    }
};

template <class Epi, class Sched>
__device__ __forceinline__ void gemm_phase(LAS unsigned char* lds, const Gemm g, const Sched& S, const Epi& E) {
    const int tid = fresh_tid(), wid = __builtin_amdgcn_readfirstlane(tid >> 6), lane = tid & 63, wr = wid >> 2, wc = wid & 3, fr = lane & 15, fq = lane >> 4;
    const int K = g.K, nt = K / BK;
    unsigned voffA[2], voffB[2];
#pragma unroll
    for (int i = 0; i < 2; ++i) { int R, C; stage_rc(tid * 16 + i * 8192, R, C); const int Rb = Epi::PERM ? ((R & ~31) + perm32(R & 31)) : R;
        voffA[i] = (unsigned)(R * K + C) * 2u; voffB[i] = (unsigned)(Rb * K + C) * 2u; }
    const size_t kstep = (size_t)(BK * 2);
    const size_t hstep = (size_t)HALF * K * 2;
    const size_t tstep = 2 * hstep;
    const unsigned ldsw = (unsigned)wid * 1024u;
    const int aoff = lds_byte(wr * 64 + fr, fq * 8), boff = lds_byte(wc * 32 + fr, fq * 8);
#define PG8_SA(b, h) (((b) * 2 + (h)) * HTB)
#define PG8_SB(b, h) ((4 + (b) * 2 + (h)) * HTB)
#define PG8_STAGE(bufoff, gbase, voff) do { _Pragma("unroll") for (int _i = 0; _i < 2; ++_i) \
        __builtin_amdgcn_global_load_lds((const unsigned*)((const char*)(gbase) + (voff)[_i]), (LAS unsigned*)(lds + (bufoff) + ldsw + _i * 8192), 16, 0, 0); } while (0)
#define PG8_LDA(dst, b, h) do { _Pragma("unroll") for (int m = 0; m < 4; ++m) _Pragma("unroll") for (int k = 0; k < 2; ++k) dst[m][k] = *(const LAS bf16x8*)(lds + PG8_SA(b, h) + aoff + m * 2048 + k * 1024); } while (0)
#define PG8_LDB(dst, b, h) do { _Pragma("unroll") for (int n = 0; n < 2; ++n) _Pragma("unroll") for (int k = 0; k < 2; ++k) dst[n][k] = *(const LAS bf16x8*)(lds + PG8_SB(b, h) + boff + n * 2048 + k * 1024); } while (0)
#define PG8_MMA(ai, bj, At, Bt) do { __builtin_amdgcn_s_setprio(1); _Pragma("unroll") for (int m = 0; m < 4; ++m) _Pragma("unroll") for (int n = 0; n < 2; ++n) _Pragma("unroll") for (int k = 0; k < 2; ++k) \
        acc[ai][bj][m][n] = __builtin_amdgcn_mfma_f32_16x16x32_bf16(Bt[n][k], At[m][k], acc[ai][bj][m][n], 0, 0, 0); __builtin_amdgcn_s_setprio(0); } while (0)
#define PG8_WAIT_V(n) asm volatile("s_waitcnt vmcnt(" #n ")" ::: "memory")
#define PG8_WAIT_L(n) asm volatile("s_waitcnt lgkmcnt(" #n ")" ::: "memory")
#define PG8_BAR __builtin_amdgcn_s_barrier()
#define PG8_SCHED __builtin_amdgcn_sched_barrier(0)
    Unit cur, nxt; int ui = 0;
    if (!S.next(0, cur)) return;
    f32x4 acc[2][2][4][2];
#pragma unroll
    for (int a = 0; a < 2; ++a)
#pragma unroll
        for (int b = 0; b < 2; ++b)
#pragma unroll
            for (int m = 0; m < 4; ++m)
#pragma unroll
                for (int n = 0; n < 2; ++n) acc[a][b][m][n] = (f32x4){0.f, 0.f, 0.f, 0.f};
    bf16x8 At[4][2], B0[2][2], B1[2][2];
    const char* cA = (const char*)g.A + (size_t)cur.pm * tstep; const char* cB = (const char*)g.Bt + (size_t)cur.pn * tstep;
    S.a_ready(cur);
    PG8_STAGE(PG8_SB(0, 0), cB, voffB); PG8_STAGE(PG8_SA(0, 0), cA, voffA); PG8_STAGE(PG8_SB(0, 1), cB + hstep, voffB); PG8_STAGE(PG8_SA(0, 1), cA + hstep, voffA);
    if (wr == 1) PG8_BAR;
    PG8_WAIT_V(4); PG8_BAR;
    PG8_STAGE(PG8_SB(1, 0), cB + kstep, voffB); PG8_STAGE(PG8_SA(1, 0), cA + kstep, voffA); PG8_STAGE(PG8_SB(1, 1), cB + hstep + kstep, voffB);
    PG8_WAIT_V(6); PG8_BAR;
    for (;;) {
        const bool has_next = S.next(ui + 1, nxt);
        const char* nA = has_next ? (const char*)g.A + (size_t)nxt.pm * tstep : cA; const char* nB = has_next ? (const char*)g.Bt + (size_t)nxt.pn * tstep : cB;
        for (int t = 0; t < nt; t += 2) {
            const bool last = (t == nt - 2);
            const char* a1 = cA + (size_t)(t + 1) * kstep;
            const char* a2 = last ? nA : cA + (size_t)(t + 2) * kstep; const char* b2 = last ? nB : cB + (size_t)(t + 2) * kstep;
            const char* a3 = a2 + kstep; const char* b3 = b2 + kstep;
            if (last && has_next) S.a_ready(nxt);
            if (Epi::HOOK && (t == 16 || t == 24)) E.mid(acc, cur, wr, wc, fr, fq, t == 16 ? 0 : 1);
            PG8_LDB(B0, 0, 0); PG8_SCHED; PG8_LDA(At, 0, 0); PG8_STAGE(PG8_SA(1, 1), a1 + hstep, voffA);
            PG8_WAIT_L(8); PG8_BAR; PG8_WAIT_L(0); PG8_MMA(0, 0, At, B0); PG8_BAR; PG8_SCHED;
            PG8_LDB(B1, 0, 1); PG8_STAGE(PG8_SB(0, 0), b2, voffB);
            PG8_BAR; PG8_WAIT_L(0); PG8_MMA(0, 1, At, B1); PG8_BAR;
            PG8_LDA(At, 0, 1); PG8_STAGE(PG8_SA(0, 0), a2, voffA);
            PG8_BAR; PG8_WAIT_L(0); PG8_MMA(1, 0, At, B0); PG8_BAR; PG8_SCHED;
            PG8_STAGE(PG8_SB(0, 1), b2 + hstep, voffB);
            PG8_WAIT_V(6); PG8_BAR; PG8_MMA(1, 1, At, B1); PG8_BAR;
            PG8_LDB(B0, 1, 0); PG8_SCHED; PG8_LDA(At, 1, 0); PG8_STAGE(PG8_SA(0, 1), a2 + hstep, voffA);
            PG8_WAIT_L(8); PG8_BAR; PG8_WAIT_L(0); PG8_MMA(0, 0, At, B0); PG8_BAR; PG8_SCHED;
            PG8_LDB(B1, 1, 1); PG8_STAGE(PG8_SB(1, 0), b3, voffB);
            PG8_BAR; PG8_WAIT_L(0); PG8_MMA(0, 1, At, B1); PG8_BAR;
            PG8_LDA(At, 1, 1); PG8_STAGE(PG8_SA(1, 0), a3, voffA);
            PG8_BAR; PG8_WAIT_L(0); PG8_MMA(1, 0, At, B0); PG8_BAR; PG8_SCHED;
            PG8_STAGE(PG8_SB(1, 1), b3 + hstep, voffB);
            PG8_WAIT_V(6); PG8_BAR; PG8_MMA(1, 1, At, B1); PG8_BAR;
        }
        E(acc, cur, wr, wc, fr, fq); S.done(cur);
        if (!has_next) break;
#pragma unroll
        for (int a = 0; a < 2; ++a)
#pragma unroll
            for (int b = 0; b < 2; ++b)
#pragma unroll
                for (int m = 0; m < 4; ++m)
#pragma unroll
                    for (int n = 0; n < 2; ++n) acc[a][b][m][n] = (f32x4){0.f, 0.f, 0.f, 0.f};
        cur = nxt; cA = nA; cB = nB; ++ui;
    }
    PG8_WAIT_V(0);
    if (wr == 0) PG8_BAR;
    PG8_BAR;
#undef PG8_SA
#undef PG8_SB
#undef PG8_STAGE
#undef PG8_LDA
#undef PG8_LDB
#undef PG8_MMA
#undef PG8_WAIT_V
#undef PG8_WAIT_L
#undef PG8_BAR
#undef PG8_SCHED
}
}

__device__ void convert_T(const float* __restrict__ W, int K, int N, int Npad, bf16_t* __restrict__ Wt, int ldw, LAS float* tile, int t0, int tstride) {
    const int tid = fresh_tid(), tk = K / 64, tn = Npad / 64, ntile = tk * tn;
    const int lk = tid >> 4, ln = (tid & 15) * 4;
    f32x4 v[2];
#define CT_LOAD(t) do { const int _k0 = ((t) % tk) * 64, _n0 = ((t) / tk) * 64; _Pragma("unroll") for (int _i = 0; _i < 2; ++_i) { v[_i] = (f32x4){0.f, 0.f, 0.f, 0.f}; \
        if (_n0 + ln < N) v[_i] = *(const f32x4*)(W + (size_t)(_k0 + lk + 32 * _i) * N + _n0 + ln); } } while (0)
    if (t0 < ntile) CT_LOAD(t0);
    for (int t = t0; t < ntile; t += tstride) {
        const int k0 = (t % tk) * 64, n0 = (t / tk) * 64;
#pragma unroll
        for (int i = 0; i < 2; ++i) { const int k = lk + 32 * i; tile[k * 65 + ln] = v[i][0]; tile[k * 65 + ln + 1] = v[i][1]; tile[k * 65 + ln + 2] = v[i][2]; tile[k * 65 + ln + 3] = v[i][3]; }
        __syncthreads();
        if (t + tstride < ntile) CT_LOAD(t + tstride);
        { const int n = tid >> 3, k8 = (tid & 7) * 8; u32x4 w;
          w.x = pk2(tile[(k8 + 0) * 65 + n], tile[(k8 + 1) * 65 + n]); w.y = pk2(tile[(k8 + 2) * 65 + n], tile[(k8 + 3) * 65 + n]);
          w.z = pk2(tile[(k8 + 4) * 65 + n], tile[(k8 + 5) * 65 + n]); w.w = pk2(tile[(k8 + 6) * 65 + n], tile[(k8 + 7) * 65 + n]);
          *(u32x4*)(Wt + (size_t)(n0 + n) * ldw + k0 + k8) = w; }
        __syncthreads();
    }
#undef CT_LOAD
}

__device__ void prenorm0(const Params& p, int bid, int nb) {
    const int tid_ = fresh_tid(); const int lane = tid_ & 63, wid = tid_ >> 6;
    bf16_t* H = (bf16_t*)(p.ws + WS_BUFA);
    const float* g = p.in[9];
    for (int r = bid * 8 + wid; r < MROWS; r += nb * 8) {
        const float* x = x0_row(p, r);
        f32x4 v[8]; float ss = 0.f;
#pragma unroll
        for (int i = 0; i < 8; ++i) { v[i] = *(const f32x4*)(x + i * 256 + lane * 4); ss += v[i][0] * v[i][0] + v[i][1] * v[i][1] + v[i][2] * v[i][2] + v[i][3] * v[i][3]; }
        ss = wave_sum(ss);
        const float rs = rsqrtf(ss * (1.0f / DM) + 1e-6f);
#pragma unroll
        for (int i = 0; i < 8; ++i) { const f32x4 gg = *(const f32x4*)(g + i * 256 + lane * 4);
            u32x2 w; w.x = pk2(v[i][0] * rs * gg[0], v[i][1] * rs * gg[1]); w.y = pk2(v[i][2] * rs * gg[2], v[i][3] * rs * gg[3]);
            *(u32x2*)(H + (size_t)r * DM + i * 256 + lane * 4) = w; }
    }
}
__device__ void postnorm(const Params& p, int layer, int bid, int nb) {
    const int tid_ = fresh_tid(); const int lane = tid_ & 63, wid = tid_ >> 6;
    const bf16_t* Y = (const bf16_t*)(p.ws + WS_BUFB);
    bf16_t* H = (bf16_t*)(p.ws + WS_BUFA);
    const float* gpost = p.in[10] + layer * DM;
    const float* gpre = p.in[9] + DM;
    for (int r = bid * 8 + wid; r < MROWS; r += nb * 8) {
        const float* x = layer == 0 ? x0_row(p, r) : x1_row(p, r);
        float* xo = x1_row(p, r);
        float yv[32]; float ss = 0.f;
#pragma unroll
        for (int i = 0; i < 4; ++i) { const u32x4 w = *(const u32x4*)(Y + (size_t)r * DM + i * 512 + lane * 8);
            yv[i * 8 + 0] = bflo(w.x); yv[i * 8 + 1] = bfhi(w.x); yv[i * 8 + 2] = bflo(w.y); yv[i * 8 + 3] = bfhi(w.y);
            yv[i * 8 + 4] = bflo(w.z); yv[i * 8 + 5] = bfhi(w.z); yv[i * 8 + 6] = bflo(w.w); yv[i * 8 + 7] = bfhi(w.w); }
#pragma unroll
        for (int i = 0; i < 32; ++i) ss += yv[i] * yv[i];
        ss = wave_sum(ss);
        const float rs = rsqrtf(ss * (1.0f / DM) + 1e-6f);
        float s2 = 0.f;
#pragma unroll
        for (int i = 0; i < 4; ++i)
#pragma unroll
            for (int h = 0; h < 2; ++h) { const int c = i * 512 + lane * 8 + h * 4;
                const f32x4 xv = *(const f32x4*)(x + c); const f32x4 gg = *(const f32x4*)(gpost + c);
                f32x4 o;
#pragma unroll
                for (int j = 0; j < 4; ++j) { o[j] = xv[j] + yv[i * 8 + h * 4 + j] * rs * gg[j]; s2 += o[j] * o[j]; yv[i * 8 + h * 4 + j] = o[j]; }
                *(f32x4*)(xo + c) = o; }
        if (layer == 0) {
            s2 = wave_sum(s2);
            const float r2 = rsqrtf(s2 * (1.0f / DM) + 1e-6f);
#pragma unroll
            for (int i = 0; i < 4; ++i) { const int c = i * 512 + lane * 8;
                const f32x4 g0 = *(const f32x4*)(gpre + c), g1 = *(const f32x4*)(gpre + c + 4);
                u32x4 w; w.x = pk2(yv[i * 8 + 0] * r2 * g0[0], yv[i * 8 + 1] * r2 * g0[1]); w.y = pk2(yv[i * 8 + 2] * r2 * g0[2], yv[i * 8 + 3] * r2 * g0[3]);
                w.z = pk2(yv[i * 8 + 4] * r2 * g1[0], yv[i * 8 + 5] * r2 * g1[1]); w.w = pk2(yv[i * 8 + 6] * r2 * g1[2], yv[i * 8 + 7] * r2 * g1[3]);
                *(u32x4*)(H + (size_t)r * DM + c) = w; }
        }
    }
}

__device__ __forceinline__ bf16_t* rarr(const Params& p, int i) { return (bf16_t*)(i < 4 ? p.ws + WS_BUFA + (size_t)i * RARR : p.ws + WS_RX + (size_t)(i - 4) * RARR); }
__device__ void rwkv_prep(const Params& p, int layer, LAS unsigned char* lds, int bid, int nb) {
    const int tid = fresh_tid();
    LAS bf16_t* PC = (LAS bf16_t*)lds;
    LAS float* XW = (LAS float*)(lds + 17 * C_COLS * 2);
    LAS float* XA = XW + 16 * 64;
    const bf16_t* P = (const bf16_t*)(p.ws + WS_P);
    const float* mu = p.in[17] + layer * C_COLS;
    const float* w0 = p.in[18] + layer * 512; const float* wup = p.in[19] + (size_t)layer * 64 * 512;
    const float* a0 = p.in[20] + layer * 512; const float* aup = p.in[21] + (size_t)layer * 64 * 512;
    const float kkc = p.in[22][layer * 512 + tid], kac = p.in[23][layer * 512 + tid], rkc = p.in[24][layer * 512 + tid];
    bf16_t* oR = rarr(p, 0); bf16_t* oU = rarr(p, 1); bf16_t* oK = rarr(p, 2); bf16_t* oV = rarr(p, 3);
    bf16_t* oKK = rarr(p, 4); bf16_t* oKA = rarr(p, 5); bf16_t* oZS = rarr(p, 6); bf16_t* oBV = rarr(p, 7);
    for (int tile = bid; tile < MROWS / 16; tile += nb) {
        const int r0 = tile * 16;
        int seq_t0, seq_T, sb; bool sample;
        if (r0 < NP_ROWS) { sb = r0 / TP; seq_t0 = r0 - sb * TP; seq_T = TP; sample = false; } else { sb = (r0 - NP_ROWS) / 64; seq_t0 = (r0 - NP_ROWS) - sb * 64; seq_T = 64; sample = true; }
        {
            u32x4 buf[10];
#pragma unroll
            for (int it = 0; it < 10; ++it) { const int i = tid + it * NTHREADS; const int rr = i / (C_COLS / 8), cc = (i - rr * (C_COLS / 8)) * 8;
                u32x4 v = (u32x4){0u, 0u, 0u, 0u};
                if (i < 17 * (C_COLS / 8)) {
                    if (rr > 0 || seq_t0 > 0) v = *(const u32x4*)(P + (size_t)r0 * NINP + C_BASE + ((rr - 1) * NINP + cc));
                    else if (sample) { const float* sh = p.in[7] + ((size_t)layer * 32 + sb) * C_COLS + cc;
                        v.x = pk2(sh[0], sh[1]); v.y = pk2(sh[2], sh[3]); v.z = pk2(sh[4], sh[5]); v.w = pk2(sh[6], sh[7]); } }
                buf[it] = v; }
#pragma unroll
            for (int it = 0; it < 10; ++it) { const int i = tid + it * NTHREADS; if (i < 17 * (C_COLS / 8)) *(LAS u32x4*)(PC + i * 8) = buf[it]; }
        }
        __syncthreads();
#pragma unroll
        for (int it = 0; it < 4; ++it) { const int i = tid + it * NTHREADS; const int tok = i >> 7, j = i & 127, col = CO_WD + j;
            const float pc = bf2f(PC[(tok + 1) * C_COLS + col]), pv = bf2f(PC[tok * C_COLS + col]);
            const float xs = pc + mu[col] * (pv - pc);
            if (j < 64) { const float e = __expf(2.f * xs); XW[tok * 64 + j] = 1.f - 2.f * __builtin_amdgcn_rcpf(e + 1.f); } else XA[tok * 64 + (j - 64)] = xs; }
        if (seq_t0 + 16 == seq_T) { float* so = p.out + (sample ? O_SHS + ((size_t)layer * 32 + sb) * C_COLS : O_SHP + ((size_t)layer * 8 + sb) * C_COLS);
            for (int i = tid; i < C_COLS; i += NTHREADS) so[i] = bf2f(PC[16 * C_COLS + i]); }
        __syncthreads();
        float aw[16], aa[16];
#pragma unroll
        for (int t = 0; t < 16; ++t) { aw[t] = 0.f; aa[t] = 0.f; }
        {
            float wu[4], au[4];
#pragma unroll
            for (int q = 0; q < 4; ++q) { wu[q] = wup[(unsigned)(q * 512 + tid)]; au[q] = aup[(unsigned)(q * 512 + tid)]; }
#pragma unroll 1
            for (int j = 0; j < 64; j += 4) {
                float nwu[4], nau[4];
                const int jn = j + 4 < 64 ? j + 4 : j;
#pragma unroll
                for (int q = 0; q < 4; ++q) { nwu[q] = wup[(unsigned)((jn + q) * 512 + tid)]; nau[q] = aup[(unsigned)((jn + q) * 512 + tid)]; }
#pragma unroll
                for (int t = 0; t < 16; ++t) { const f32x4 xw = *(const LAS f32x4*)(XW + t * 64 + j), xa = *(const LAS f32x4*)(XA + t * 64 + j);
                    aw[t] += xw[0] * wu[0] + xw[1] * wu[1] + xw[2] * wu[2] + xw[3] * wu[3];
                    aa[t] += xa[0] * au[0] + xa[1] * au[1] + xa[2] * au[2] + xa[3] * au[3]; }
#pragma unroll
                for (int q = 0; q < 4; ++q) { wu[q] = nwu[q]; au[q] = nau[q]; }
            }
        }
        const float w0c = w0[tid], a0c = a0[tid];
        const float mur = mu[CO_R + tid], muk = mu[CO_K + tid], muv = mu[CO_V + tid], muz = mu[CO_Z + tid];
#pragma unroll 4
        for (int t = 0; t < 16; ++t) {
            const LAS bf16_t* pc = PC + (t + 1) * C_COLS; const LAS bf16_t* pp = PC + t * C_COLS;
            float c_, q_;
            c_ = bf2f(pc[CO_R + tid]); q_ = bf2f(pp[CO_R + tid]); const float r = c_ + mur * (q_ - c_);
            c_ = bf2f(pc[CO_K + tid]); q_ = bf2f(pp[CO_K + tid]); const float k = c_ + muk * (q_ - c_);
            c_ = bf2f(pc[CO_V + tid]); q_ = bf2f(pp[CO_V + tid]); const float v = c_ + muv * (q_ - c_);
            c_ = bf2f(pc[CO_Z + tid]); q_ = bf2f(pp[CO_Z + tid]); const float z = c_ + muz * (q_ - c_);
            const float e = sigmoidf_(w0c + aw[t]) * 0.60653066f;
            const float u = 1.f - __expf(-e);
            const float a = sigmoidf_(a0c + aa[t]);
            float kk = k * kkc;
            kk = kk * __builtin_amdgcn_rsqf(fmaxf(wave_sum_fast(kk * kk), 1e-24f));
            const float kt = k * (1.f + (a - 1.f) * kac);
            const float rk = wave_sum_fast(r * kt * rkc);
            const float zs = z * sigmoidf_(z);
            const size_t o = (size_t)(r0 + t) * 512 + tid;
            oR[o] = f2bf(r); oU[o] = f2bf(u); oK[o] = f2bf(kt); oV[o] = f2bf(v); oKK[o] = f2bf(kk); oKA[o] = f2bf(kk * a); oZS[o] = f2bf(zs); oBV[o] = f2bf(rk * v * zs);
        }
        __syncthreads();
    }
}

__device__ void rwkv_scan(const Params& p, int layer, int bseq, int head, int half, bool sample, LAS unsigned char* lds) {
    const int tid = fresh_tid(), row = tid >> 4, part = tid & 15;
    LAS float* LR = (LAS float*)lds;
    LAS float* LU = LR + 4096; LAS float* LK = LU + 4096; LAS float* LKK = LK + 4096; LAS float* LKA = LKK + 4096; LAS float* LV = LKA + 4096; LAS float* LY = LV + 4096;
    const int row_base = sample ? NP_ROWS + bseq * 64 : bseq * TP;
    const int T = sample ? 64 : TP;
    const int nch = (T + 63) / 64;
    const int vrow = half * 32 + row;
    f32x2 sA = (f32x2){0.f, 0.f}, sB = sA;
    if (sample) { const float* S = p.in[6] + ((((size_t)layer * 32 + bseq) * 8 + head) * 64) * 64;
        const f32x4 s = *(const f32x4*)(S + (unsigned)(vrow * 64 + part * 4)); sA = (f32x2){s[0], s[1]}; sB = (f32x2){s[2], s[3]}; }
    const int st = tid >> 3, sp = (tid & 7) * 8;
    const unsigned poff = (unsigned)(st * 512 + sp);
    u32x4 pf[6];
#define RW_PREFETCH(c) do { const int _t = (c) * 64 + st; if (_t < T) { const size_t _o = (size_t)(row_base + (c) * 64) * 512 + head * 64; \
        _Pragma("unroll") for (int _i = 0; _i < 6; ++_i) pf[_i] = *(const u32x4*)(rarr(p, _i) + _o + poff); } \
        else { _Pragma("unroll") for (int _i = 0; _i < 6; ++_i) pf[_i] = (u32x4){0u, 0u, 0u, 0u}; } } while (0)
    RW_PREFETCH(0);
    float* YR = (float*)(p.ws + WS_YRAW);
    for (int c = 0; c < nch; ++c) {
        const int L = (T - c * 64) < 64 ? (T - c * 64) : 64;
        {
            LAS float* dst[6] = {LR, LU, LK, LV, LKK, LKA};
#pragma unroll
            for (int i = 0; i < 6; ++i) { const u32x4 w = pf[i]; LAS float* d = dst[i] + st * 64 + sp;
                *(LAS f32x4*)d = (f32x4){bflo(w.x), bfhi(w.x), bflo(w.y), bfhi(w.y)}; *(LAS f32x4*)(d + 4) = (f32x4){bflo(w.z), bfhi(w.z), bflo(w.w), bfhi(w.w)}; }
        }
        __syncthreads();
        if (c + 1 < nch) RW_PREFETCH(c + 1);
        {
            const LAS float* qkk = LKK + part * 4; const LAS float* qu = LU + part * 4; const LAS float* qka = LKA + part * 4; const LAS float* qk = LK + part * 4; const LAS float* qr = LR + part * 4;
            const LAS float* qv = LV + vrow; LAS float* qy = LY + row;
            f32x4 kk = *(const LAS f32x4*)qkk, u = *(const LAS f32x4*)qu, ka = *(const LAS f32x4*)qka, k = *(const LAS f32x4*)qk, r = *(const LAS f32x4*)qr; float v = *qv; float ykeep = 0.f;
#pragma unroll 2
            for (int t = 0; t < L; ++t) {
                const int tn = (t + 1 < 64 ? t + 1 : 63) * 64;
                const f32x4 nkk = *(const LAS f32x4*)(qkk + tn), nu = *(const LAS f32x4*)(qu + tn), nka = *(const LAS f32x4*)(qka + tn), nk = *(const LAS f32x4*)(qk + tn), nr = *(const LAS f32x4*)(qr + tn);
                const float nv = qv[tn];
                const f32x2 d2 = sA * (f32x2){kk[0], kk[1]} + sB * (f32x2){kk[2], kk[3]};
                const float sa = -row16_sum(d2[0] + d2[1]);
                const f32x2 sa2 = (f32x2){sa, sa}, v2 = (f32x2){v, v};
                sA = sa2 * (f32x2){ka[0], ka[1]} + (v2 * (f32x2){k[0], k[1]} + (sA - sA * (f32x2){u[0], u[1]}));
                sB = sa2 * (f32x2){ka[2], ka[3]} + (v2 * (f32x2){k[2], k[3]} + (sB - sB * (f32x2){u[2], u[3]}));
                const f32x2 y2 = sA * (f32x2){r[0], r[1]} + sB * (f32x2){r[2], r[3]};
                const float y = row16_sum(y2[0] + y2[1]);
                ykeep = ((t & 15) == part) ? y : ykeep;
                if ((t & 15) == 15) qy[(t - 15 + part) * 32] = ykeep;
                kk = nkk; u = nu; ka = nka; k = nk; r = nr; v = nv;
            }
        }
        __syncthreads();
        { const int t = tid >> 3, r4 = (tid & 7) * 4;
          if (t < L) *(f32x4*)(YR + (size_t)(row_base + c * 64) * 512 + head * 64 + half * 32 + (unsigned)(t * 512 + r4)) = *(const LAS f32x4*)(LY + t * 32 + r4); }
        __syncthreads();
    }
#undef RW_PREFETCH
    { float* So = p.out + (sample ? O_RS + ((((size_t)layer * 32 + bseq) * 8 + head) * 64) * 64 : O_RP + ((((size_t)layer * 8 + bseq) * 8 + head) * 64) * 64);
      *(f32x4*)(So + (unsigned)(vrow * 64 + part * 4)) = (f32x4){sA[0], sA[1], sB[0], sB[1]}; }
    __syncthreads();
}

__device__ void rwkv_post(const Params& p, int layer, int bid, int nb) {
    const int tid = fresh_tid(), lane = tid & 63, wid = tid >> 6;
    const float* YR = (const float*)(p.ws + WS_YRAW);
    const bf16_t* ZS = rarr(p, 6); const bf16_t* BV = rarr(p, 7);
    bf16_t* YC = (bf16_t*)(p.ws + WS_BUFB) + 1536;
    const float* gng = p.in[25] + layer * 512; const float* gnb = p.in[26] + layer * 512;
    const unsigned co = (unsigned)(lane * 8);
    const f32x4 g0 = *(const f32x4*)(gng + co), g1 = *(const f32x4*)(gng + co + 4), b0 = *(const f32x4*)(gnb + co), b1 = *(const f32x4*)(gnb + co + 4);
    const float gg[8] = {g0[0], g0[1], g0[2], g0[3], g1[0], g1[1], g1[2], g1[3]}, bb[8] = {b0[0], b0[1], b0[2], b0[3], b1[0], b1[1], b1[2], b1[3]};
    for (int r = bid * 8 + wid; r < MROWS; r += nb * 8) {
        const f32x4 ya = *(const f32x4*)(YR + (size_t)r * 512 + co), yb = *(const f32x4*)(YR + (size_t)r * 512 + co + 4);
        const u32x4 zs = *(const u32x4*)(ZS + (size_t)r * 512 + co), bv = *(const u32x4*)(BV + (size_t)r * 512 + co);
        float y[8] = {ya[0], ya[1], ya[2], ya[3], yb[0], yb[1], yb[2], yb[3]};
        float sm = 0.f;
#pragma unroll
        for (int j = 0; j < 8; ++j) sm += y[j];
        sm += dppf<0xB1>(sm); sm += dppf<0x4E>(sm); sm += dppf<0x141>(sm);
        const float mean = sm * (1.f / 64.f);
        float sv = 0.f;
#pragma unroll
        for (int j = 0; j < 8; ++j) { y[j] -= mean; sv += y[j] * y[j]; }
        sv += dppf<0xB1>(sv); sv += dppf<0x4E>(sv); sv += dppf<0x141>(sv);
        const float rstd = rsqrtf(sv * (1.f / 64.f) + 64e-5f);
        const float zz[8] = {bflo(zs.x), bfhi(zs.x), bflo(zs.y), bfhi(zs.y), bflo(zs.z), bfhi(zs.z), bflo(zs.w), bfhi(zs.w)};
        const float vv[8] = {bflo(bv.x), bfhi(bv.x), bflo(bv.y), bfhi(bv.y), bflo(bv.z), bfhi(bv.z), bflo(bv.w), bfhi(bv.w)};
        float o[8];
#pragma unroll
        for (int j = 0; j < 8; ++j) o[j] = (y[j] * rstd * gg[j] + bb[j]) * zz[j] + vv[j];
        u32x4 w; w.x = pk2(o[0], o[1]); w.y = pk2(o[2], o[3]); w.z = pk2(o[4], o[5]); w.w = pk2(o[6], o[7]);
        *(u32x4*)(YC + (size_t)r * 2048 + co) = w;
    }
}

constexpr int QS_LD = 136, VT_LD = 72, HO_LD = 132;
constexpr int L_QS = 0, L_KS = L_QS + 64 * QS_LD * 2, L_VT = L_KS + 64 * QS_LD * 2, L_KT = L_VT + 144 * VT_LD * 2, L_CB = L_KT + 128 * VT_LD * 2,
              L_SS = L_CB + 144 * QS_LD * 2, L_HO = L_SS + 64 * VT_LD * 2, L_GT = L_HO + 64 * HO_LD * 4, L_END = L_GT + 6144;
static_assert(L_END <= LDS_BYTES, "LDS overflow");
constexpr int G_B = 0, G_IG = 64, G_MT = 128, G_WI = 192, G_EMT = 256, G_WS = 320, G_DEN = 384, G_AMID = 448, G_AEND = 576, G_TOT = 704, G_LB = 1216, G_SC = 1344;

#define FRESH_IDS int T_ = threadIdx.x; asm volatile("" : "+v"(T_)); const int lane = T_ & 63; const int wid = __builtin_amdgcn_readfirstlane(T_ >> 6); \
    const int l15 = lane & 15, lq = lane >> 4, st = T_ >> 3, sp = (T_ & 7) * 16; (void)lane; (void)wid; (void)l15; (void)lq; (void)st; (void)sp;
template <int KIND>
__device__ void chunk_unit(const Params& p, int layer, int bseq, int head, bool sample, LAS unsigned char* lds) {
    constexpr int NVT = KIND == 0 ? 9 : 8;
    LAS bf16_t* QS = (LAS bf16_t*)(lds + L_QS); LAS bf16_t* KS = (LAS bf16_t*)(lds + L_KS); LAS bf16_t* VT = (LAS bf16_t*)(lds + L_VT);
    LAS bf16_t* KT = (LAS bf16_t*)(lds + L_KT); LAS bf16_t* CB = (LAS bf16_t*)(lds + L_CB); LAS bf16_t* SS = (LAS bf16_t*)(lds + L_SS);
    LAS float* HO = (LAS float*)(lds + L_HO); LAS float* GT = (LAS float*)(lds + L_GT);
    const bf16_t* P = (const bf16_t*)(p.ws + WS_P);
    const int cq = KIND == 0 ? A_Q + head * 128 : B_Q + head * 128;
    const int ck = KIND == 0 ? A_K + head * 128 : B_F + head * 128;
    const int cv = KIND == 0 ? A_V + head * 128 : B_I + head * 128;
    const int cz = KIND == 0 ? A_Z + head * 128 : B_Z + head * 128;
    const int co = A_O + head * 128;
    const int row_base = sample ? NP_ROWS + bseq * 64 : bseq * TP;
    const int nchunks = sample ? 1 : 33;
    const int NB = sample ? 32 : 8;

    f32x4 C[NVT];
#pragma unroll
    for (int vt = 0; vt < NVT; ++vt) C[vt] = (f32x4){0.f, 0.f, 0.f, 0.f};
    float m_run = 0.f;
    {
        FRESH_IDS
        if (sample) {
            if (KIND == 0) {
                const float* Cin = p.in[2] + ((((size_t)layer * 32 + bseq) * 8 + head) * 128) * 128;
#pragma unroll
                for (int vt = 0; vt < 8; ++vt)
#pragma unroll
                    for (int j = 0; j < 4; ++j) C[vt][j] = Cin[(unsigned)((vt * 16 + lq * 4 + j) * 128 + wid * 16 + l15)];
                if (lq == 0) C[NVT - 1][0] = (p.in[3] + (((size_t)layer * 32 + bseq) * 8 + head) * 128)[(unsigned)(wid * 16 + l15)];
                m_run = p.in[4][((size_t)layer * 32 + bseq) * 8 + head];
            } else {
                const float* Sin = p.in[5] + ((((size_t)layer * 32 + bseq) * 4 + head) * 128) * 128;
#pragma unroll
                for (int vt = 0; vt < 8; ++vt) C[vt] = *(const f32x4*)(Sin + (unsigned)((wid * 16 + l15) * 128 + vt * 16 + lq * 4));
            }
        }
        if (KIND == 0) { for (int i = T_; i < 16 * 64; i += NTHREADS) { const int rr = i >> 6, ss = i & 63; VT[(128 + rr) * VT_LD + ss] = rr == 0 ? (bf16_t)0x3F80 : (bf16_t)0; } }
        else if (T_ < 128) { float lb = 0.f; if (layer == 1) { const float l0 = p.in[15][head * 128 + T_], l1 = p.in[15][512 + head * 128 + T_]; lb = sigmoidf_(l1 - l0); } GT[G_LB + T_] = lb; }
    }
    const float b_i = KIND == 0 ? p.in[12][layer * 8 + head] : 0.f, b_f = KIND == 0 ? p.in[13][layer * 8 + head] : 0.f;

    u32x4 pq[2], pk[2], pv[2]; bf16_t pgi = 0, pgf = 0;
#define CU_PREFETCH(c) do { FRESH_IDS const int _t0 = sample ? 0 : ((c) == 0 ? 0 : 16 + 64 * ((c) - 1)); const int _L = (!sample && (c) == 0) ? 16 : 64; \
        const bf16_t* _r = P + (size_t)(row_base + _t0) * NINP; const unsigned toff = (unsigned)(st * NINP + sp); \
        if (st < _L) { \
            pq[0] = *(const u32x4*)(_r + cq + toff); pq[1] = *(const u32x4*)(_r + cq + 8 + toff); pk[0] = *(const u32x4*)(_r + ck + toff); pk[1] = *(const u32x4*)(_r + ck + 8 + toff); \
            pv[0] = *(const u32x4*)(_r + cv + toff); pv[1] = *(const u32x4*)(_r + cv + 8 + toff); } \
        else { pq[0] = pq[1] = pk[0] = pk[1] = pv[0] = pv[1] = (u32x4){0u, 0u, 0u, 0u}; } \
        if (KIND == 0 && T_ < 64) { if (T_ < _L) { const unsigned goff = (unsigned)(T_ * NINP); pgi = (_r + A_I + head)[goff]; pgf = (_r + A_F + head)[goff]; } } } while (0)
    CU_PREFETCH(0);
    if (KIND == 1) __syncthreads();

    for (int c = 0; c < nchunks; ++c) {
        const int t0 = sample ? 0 : (c == 0 ? 0 : 16 + 64 * (c - 1));
        const int L = (!sample && c == 0) ? 16 : 64;
        float qf[16], kf[16];
        {
            FRESH_IDS
            const unsigned qw[8] = {pq[0].x, pq[0].y, pq[0].z, pq[0].w, pq[1].x, pq[1].y, pq[1].z, pq[1].w};
            const unsigned kw[8] = {pk[0].x, pk[0].y, pk[0].z, pk[0].w, pk[1].x, pk[1].y, pk[1].z, pk[1].w};
            const unsigned vw[8] = {pv[0].x, pv[0].y, pv[0].z, pv[0].w, pv[1].x, pv[1].y, pv[1].z, pv[1].w};
            (void)qw;
            { LAS bf16_t* vtp = VT + sp * VT_LD + st;
#pragma unroll
              for (int j = 0; j < 8; ++j) { vtp[(2 * j) * VT_LD] = (bf16_t)(vw[j] & 0xffffu); vtp[(2 * j + 1) * VT_LD] = (bf16_t)(vw[j] >> 16); } }
            if (KIND == 0) {
                *(LAS u32x4*)(QS + st * QS_LD + sp) = pq[0]; *(LAS u32x4*)(QS + st * QS_LD + sp + 8) = pq[1];
                u32x4 k0, k1; const float sc = 0.08838834764831845f;
                k0.x = pk2(bflo(kw[0]) * sc, bfhi(kw[0]) * sc); k0.y = pk2(bflo(kw[1]) * sc, bfhi(kw[1]) * sc); k0.z = pk2(bflo(kw[2]) * sc, bfhi(kw[2]) * sc); k0.w = pk2(bflo(kw[3]) * sc, bfhi(kw[3]) * sc);
                k1.x = pk2(bflo(kw[4]) * sc, bfhi(kw[4]) * sc); k1.y = pk2(bflo(kw[5]) * sc, bfhi(kw[5]) * sc); k1.z = pk2(bflo(kw[6]) * sc, bfhi(kw[6]) * sc); k1.w = pk2(bflo(kw[7]) * sc, bfhi(kw[7]) * sc);
                *(LAS u32x4*)(KS + st * QS_LD + sp) = k0; *(LAS u32x4*)(KS + st * QS_LD + sp + 8) = k1;
                pk[0] = k0; pk[1] = k1;
                if (wid == 0) {
                    const float ig = lane < L ? bf2f(pgi) + b_i : -1e30f;
                    const float lf = lane < L ? logsigmoidf_(bf2f(pgf) + b_f) : 0.f;
                    float b = lf;
#pragma unroll
                    for (int d = 1; d < 64; d <<= 1) { const float y = __shfl_up(b, d); if (lane >= d) b += y; }
                    float pm = ig - b;
#pragma unroll
                    for (int d = 1; d < 64; d <<= 1) { const float y = __shfl_up(pm, d); if (lane >= d) pm = fmaxf(pm, y); }
                    const float b_end = __shfl(b, 63), pm_end = __shfl(pm, 63);
                    const float mt = b + fmaxf(m_run, pm);
                    const float m_new = b_end + fmaxf(m_run, pm_end);
                    GT[G_B + lane] = b; GT[G_IG + lane] = ig; GT[G_MT + lane] = mt; GT[G_WI + lane] = __expf(b + m_run - mt); GT[G_EMT + lane] = __expf(-mt);
                    GT[G_WS + lane] = __expf(b_end - b + ig - m_new);
                    if (lane == 0) { GT[G_SC + 0] = __expf(b_end + m_run - m_new); GT[G_SC + 1] = m_new; }
                }
                { LAS bf16_t* cbp = CB + (lq * 4) * QS_LD + wid * 16 + l15;
#pragma unroll
                  for (int vt = 0; vt < NVT; ++vt)
#pragma unroll
                    for (int j = 0; j < 4; ++j) cbp[(vt * 16 + j) * QS_LD] = f2bf(C[vt][j]); }
            } else {
#pragma unroll
                for (int j = 0; j < 8; ++j) {
#pragma unroll
                    for (int h = 0; h < 2; ++h) { const int e = 2 * j + h;
                        const float fp = h ? bfhi(kw[j]) : bflo(kw[j]); qf[e] = h ? bfhi(qw[j]) : bflo(qw[j]);
                        const float lb = GT[G_LB + sp + e]; const float sg = sigmoidf_(fp);
                        float lf = __logf(lb + (1.f - lb) * sg); float kk = (1.f - lb) * (1.f - sg);
                        if (st >= L) { lf = 0.f; kk = 0.f; }
                        kf[e] = kk; HO[st * HO_LD + sp + e] = lf; }
                }
            }
        }
        __syncthreads();
        float w_old = 1.f, m_new = 0.f;
        if (KIND == 0) {
            FRESH_IDS
            w_old = GT[G_SC + 0]; m_new = GT[G_SC + 1];
            const float wsv = GT[G_WS + st];
            const unsigned kw[8] = {pk[0].x, pk[0].y, pk[0].z, pk[0].w, pk[1].x, pk[1].y, pk[1].z, pk[1].w};
            LAS bf16_t* ktp = KT + sp * VT_LD + st;
#pragma unroll
            for (int j = 0; j < 8; ++j) { ktp[(2 * j) * VT_LD] = f2bf(bflo(kw[j]) * wsv); ktp[(2 * j + 1) * VT_LD] = f2bf(bfhi(kw[j]) * wsv); }
        } else {
            { FRESH_IDS const int k = T_ & 127, tg = T_ >> 7; float run = 0.f; LAS float* hp = HO + (tg * 16) * HO_LD + k;
#pragma unroll
              for (int i = 0; i < 16; ++i) { run += hp[i * HO_LD]; hp[i * HO_LD] = run; }
              GT[G_TOT + tg * 128 + k] = run; }
            __syncthreads();
            { FRESH_IDS const int k = T_ & 127, tg = T_ >> 7; float off = 0.f; LAS float* hp = HO + (tg * 16) * HO_LD + k;
              for (int g = 0; g < tg; ++g) off += GT[G_TOT + g * 128 + k];
              if (tg > 0) {
#pragma unroll
                  for (int i = 0; i < 16; ++i) hp[i * HO_LD] += off; }
              if (tg == 1) GT[G_AMID + k] = hp[15 * HO_LD];
              if (tg == 3) GT[G_AEND + k] = hp[15 * HO_LD]; }
            __syncthreads();
            {
                FRESH_IDS
                unsigned qa[8], kb[8];
                LAS bf16_t* ktp = KT + sp * VT_LD + st; LAS float* hp = HO + st * HO_LD + sp; LAS float* gm = GT + G_AMID + sp; LAS float* ge = GT + G_AEND + sp;
#pragma unroll
                for (int j = 0; j < 8; ++j) { float qv[2], kv[2];
#pragma unroll
                    for (int h = 0; h < 2; ++h) { const int e = 2 * j + h; const float a = hp[e], am = gm[e], ae = ge[e];
                        qv[h] = qf[e] * __expf(a - am); kv[h] = kf[e] * __expf(am - a);
                        ktp[e * VT_LD] = f2bf(kf[e] * __expf(ae - a)); }
                    qa[j] = pk2(qv[0], qv[1]); kb[j] = pk2(kv[0], kv[1]); }
                *(LAS u32x4*)(QS + st * QS_LD + sp) = (u32x4){qa[0], qa[1], qa[2], qa[3]}; *(LAS u32x4*)(QS + st * QS_LD + sp + 8) = (u32x4){qa[4], qa[5], qa[6], qa[7]};
                *(LAS u32x4*)(KS + st * QS_LD + sp) = (u32x4){kb[0], kb[1], kb[2], kb[3]}; *(LAS u32x4*)(KS + st * QS_LD + sp + 8) = (u32x4){kb[4], kb[5], kb[6], kb[7]};
                const float eam = __expf(GT[G_AMID + wid * 16 + l15]);
                LAS bf16_t* cbp = CB + (lq * 4) * QS_LD + wid * 16 + l15;
#pragma unroll
                for (int vt = 0; vt < NVT; ++vt)
#pragma unroll
                    for (int j = 0; j < 4; ++j) cbp[(vt * 16 + j) * QS_LD] = f2bf(C[vt][j] * eam);
            }
            __syncthreads();
        }
        if (c + 1 < nchunks) CU_PREFETCH(c + 1);
        {
            FRESH_IDS
            const int ti = wid >> 1;
#pragma unroll
            for (int sjj = 0; sjj < 2; ++sjj) {
                const int sj = 2 * (wid & 1) + sjj;
                f32x4 a = (f32x4){0.f, 0.f, 0.f, 0.f};
                const LAS bf16_t* qp = QS + (ti * 16 + l15) * QS_LD + lq * 8; const LAS bf16_t* kp = KS + (sj * 16 + l15) * QS_LD + lq * 8;
#pragma unroll
                for (int kk = 0; kk < 4; ++kk) { const bf16x8 fa = *(const LAS bf16x8*)(qp + kk * 32); const bf16x8 fb = *(const LAS bf16x8*)(kp + kk * 32);
                    a = __builtin_amdgcn_mfma_f32_16x16x32_bf16(fa, fb, a, 0, 0, 0); }
                const int s = sj * 16 + l15;
                const float cs_ = KIND == 0 ? GT[G_IG + s] - GT[G_B + s] : 0.f;
                LAS bf16_t* ssp = SS + (ti * 16 + lq * 4) * VT_LD + s;
#pragma unroll
                for (int j = 0; j < 4; ++j) { const int t = ti * 16 + lq * 4 + j; float val;
                    if (KIND == 0) { const float arg = s <= t ? (GT[G_B + t] - GT[G_MT + t]) + cs_ : -1e30f; val = a[j] * __expf(arg); } else val = s <= t ? a[j] : 0.f;
                    ssp[j * VT_LD] = f2bf(val); }
            }
        }
        f32x4 hacc[5];
#pragma unroll
        for (int i = 0; i < 5; ++i) hacc[i] = (f32x4){0.f, 0.f, 0.f, 0.f};
        {
            FRESH_IDS
            const int hti = wid & 3, hv0 = (wid >> 2) * 4;
            const LAS bf16_t* qp = QS + (hti * 16 + l15) * QS_LD + lq * 8; const LAS bf16_t* cp = CB + (hv0 * 16 + l15) * QS_LD + lq * 8; const LAS bf16_t* cn = CB + (128 + l15) * QS_LD + lq * 8;
#pragma unroll
            for (int kk = 0; kk < 4; ++kk) {
                const bf16x8 fa = *(const LAS bf16x8*)(qp + kk * 32);
#pragma unroll
                for (int i = 0; i < 4; ++i) { const bf16x8 fb = *(const LAS bf16x8*)(cp + i * 16 * QS_LD + kk * 32); hacc[i] = __builtin_amdgcn_mfma_f32_16x16x32_bf16(fa, fb, hacc[i], 0, 0, 0); }
                if (KIND == 0 && wid < 4) { const bf16x8 fb = *(const LAS bf16x8*)(cn + kk * 32); hacc[4] = __builtin_amdgcn_mfma_f32_16x16x32_bf16(fa, fb, hacc[4], 0, 0, 0); }
                __builtin_amdgcn_sched_barrier(0);
            }
            if (KIND == 0) {
#pragma unroll
                for (int j = 0; j < 4; ++j) { const float wi = GT[G_WI + hti * 16 + lq * 4 + j];
#pragma unroll
                    for (int i = 0; i < 5; ++i) hacc[i][j] *= wi; }
            }
        }
        __syncthreads();
        u32x4 pz[2], po[2];
        {
            FRESH_IDS
            const int hti = wid & 3, hv0 = (wid >> 2) * 4;
            const LAS bf16_t* sp_ = SS + (hti * 16 + l15) * VT_LD + lq * 8; const LAS bf16_t* vp = VT + (hv0 * 16 + l15) * VT_LD + lq * 8; const LAS bf16_t* vn = VT + (128 + l15) * VT_LD + lq * 8;
#pragma unroll
            for (int kk = 0; kk < 2; ++kk) {
                const bf16x8 fa = *(const LAS bf16x8*)(sp_ + kk * 32);
#pragma unroll
                for (int i = 0; i < 4; ++i) { const bf16x8 fb = *(const LAS bf16x8*)(vp + i * 16 * VT_LD + kk * 32); hacc[i] = __builtin_amdgcn_mfma_f32_16x16x32_bf16(fa, fb, hacc[i], 0, 0, 0); }
                if (KIND == 0 && wid < 4) { const bf16x8 fb = *(const LAS bf16x8*)(vn + kk * 32); hacc[4] = __builtin_amdgcn_mfma_f32_16x16x32_bf16(fa, fb, hacc[4], 0, 0, 0); }
                __builtin_amdgcn_sched_barrier(0);
            }
            { const bf16_t* r_ = P + (size_t)(row_base + t0) * NINP; const unsigned zo = st < L ? (unsigned)(st * NINP + sp) : (unsigned)sp;
              pz[0] = *(const u32x4*)(r_ + cz + zo); pz[1] = *(const u32x4*)(r_ + cz + 8 + zo);
              if (KIND == 0) { po[0] = *(const u32x4*)(r_ + co + zo); po[1] = *(const u32x4*)(r_ + co + 8 + zo); } }
            if (KIND == 0) {
                if (wid < 4 && l15 == 0) {
#pragma unroll
                    for (int j = 0; j < 4; ++j) GT[G_DEN + hti * 16 + lq * 4 + j] = hacc[4][j]; }
                __syncthreads();
                LAS float* hp = HO + (hti * 16 + lq * 4) * HO_LD + hv0 * 16 + l15;
#pragma unroll
                for (int j = 0; j < 4; ++j) { const int t = hti * 16 + lq * 4 + j; const float dn = __builtin_amdgcn_rcpf(fmaxf(fabsf(GT[G_DEN + t]), GT[G_EMT + t]));
#pragma unroll
                    for (int i = 0; i < 4; ++i) hp[j * HO_LD + i * 16] = hacc[i][j] * dn; }
            } else {
                LAS float* hp = HO + (hti * 16 + lq * 4) * HO_LD + hv0 * 16 + l15;
#pragma unroll
                for (int j = 0; j < 4; ++j) {
#pragma unroll
                    for (int i = 0; i < 4; ++i) hp[j * HO_LD + i * 16] = hacc[i][j]; }
            }
        }
        __syncthreads();
        {
            FRESH_IDS
            float hv[16];
#pragma unroll
            for (int q = 0; q < 4; ++q) { const f32x4 x = *(const LAS f32x4*)(HO + st * HO_LD + sp + q * 4); hv[q * 4] = x[0]; hv[q * 4 + 1] = x[1]; hv[q * 4 + 2] = x[2]; hv[q * 4 + 3] = x[3]; }
            float rs;
            if (KIND == 0) {
                float sm = 0.f;
#pragma unroll
                for (int j = 0; j < 16; ++j) sm += hv[j];
                sm += __shfl_xor(sm, 1); sm += __shfl_xor(sm, 2); sm += __shfl_xor(sm, 4);
                const float mean = sm * (1.f / 128.f); float sv = 0.f;
#pragma unroll
                for (int j = 0; j < 16; ++j) { hv[j] -= mean; sv += hv[j] * hv[j]; }
                sv += __shfl_xor(sv, 1); sv += __shfl_xor(sv, 2); sv += __shfl_xor(sv, 4);
                rs = rsqrtf(sv * (1.f / 128.f) + 1e-6f);
            } else {
                float sv = 0.f;
#pragma unroll
                for (int j = 0; j < 16; ++j) sv += hv[j] * hv[j];
                sv += __shfl_xor(sv, 1); sv += __shfl_xor(sv, 2); sv += __shfl_xor(sv, 4);
                rs = rsqrtf(sv * (1.f / 128.f) + 1e-6f);
            }
            const float* nwb = (KIND == 0 ? p.in[14] + layer * 1024 : p.in[16] + layer * 512) + head * 128; float nw[16];
#pragma unroll
            for (int q = 0; q < 4; ++q) { const f32x4 x = *(const f32x4*)(nwb + (unsigned)(sp + q * 4)); nw[q * 4] = x[0]; nw[q * 4 + 1] = x[1]; nw[q * 4 + 2] = x[2]; nw[q * 4 + 3] = x[3]; }
            const unsigned zw[8] = {pz[0].x, pz[0].y, pz[0].z, pz[0].w, pz[1].x, pz[1].y, pz[1].z, pz[1].w};
            unsigned ow[8] = {0, 0, 0, 0, 0, 0, 0, 0};
            if (KIND == 0) { ow[0] = po[0].x; ow[1] = po[0].y; ow[2] = po[0].z; ow[3] = po[0].w; ow[4] = po[1].x; ow[5] = po[1].y; ow[6] = po[1].z; ow[7] = po[1].w; }
            unsigned res[8];
#pragma unroll
            for (int j = 0; j < 8; ++j) { float o2[2];
#pragma unroll
                for (int h = 0; h < 2; ++h) { const int e = 2 * j + h; const float z = h ? bfhi(zw[j]) : bflo(zw[j]);
                    float o = hv[e] * rs * nw[e] * (z * sigmoidf_(z));
                    if (KIND == 0) { const float og = h ? bfhi(ow[j]) : bflo(ow[j]); o *= sigmoidf_(og); }
                    o2[h] = o; }
                res[j] = pk2(o2[0], o2[1]); }
            if (st < L) {
                bf16_t* Yb = (bf16_t*)(p.ws + WS_BUFB) + (size_t)(row_base + t0) * 2048 + (KIND == 0 ? 0 : 1024) + head * 128;
                const unsigned yo = (unsigned)(st * 2048 + sp);
                *(u32x4*)(Yb + yo) = (u32x4){res[0], res[1], res[2], res[3]}; *(u32x4*)(Yb + 8 + yo) = (u32x4){res[4], res[5], res[6], res[7]};
            }
        }
        {
            FRESH_IDS
            float csc = w_old;
            if (KIND == 1) csc = __expf(GT[G_AEND + wid * 16 + l15]);
#pragma unroll
            for (int vt = 0; vt < NVT; ++vt) C[vt] *= csc;
            const LAS bf16_t* kp = KT + (wid * 16 + l15) * VT_LD + lq * 8; const LAS bf16_t* vp = VT + l15 * VT_LD + lq * 8;
#pragma unroll
            for (int kk = 0; kk < 2; ++kk) {
                const bf16x8 fb = *(const LAS bf16x8*)(kp + kk * 32);
#pragma unroll
                for (int vt = 0; vt < NVT; ++vt) { const bf16x8 fa = *(const LAS bf16x8*)(vp + vt * 16 * VT_LD + kk * 32); C[vt] = __builtin_amdgcn_mfma_f32_16x16x32_bf16(fa, fb, C[vt], 0, 0, 0); }
                __builtin_amdgcn_sched_barrier(0);
            }
            m_run = m_new;
        }
        __syncthreads();
    }
#undef CU_PREFETCH
    {
        FRESH_IDS
        if (KIND == 0) {
            float* Co = p.out + (sample ? O_CS : O_CP) + ((((size_t)layer * NB + bseq) * 8 + head) * 128) * 128;
#pragma unroll
            for (int vt = 0; vt < 8; ++vt)
#pragma unroll
                for (int j = 0; j < 4; ++j) Co[(unsigned)((vt * 16 + lq * 4 + j) * 128 + wid * 16 + l15)] = C[vt][j];
            if (lq == 0) (p.out + (sample ? O_NS : O_NP) + (((size_t)layer * NB + bseq) * 8 + head) * 128)[(unsigned)(wid * 16 + l15)] = C[NVT - 1][0];
            if (T_ == 0) p.out[(sample ? O_MS : O_MP) + ((size_t)layer * NB + bseq) * 8 + head] = m_run;
        } else {
            float* So = p.out + (sample ? O_HS : O_HP) + ((((size_t)layer * NB + bseq) * 4 + head) * 128) * 128;
#pragma unroll
            for (int vt = 0; vt < 8; ++vt) *(f32x4*)(So + (unsigned)((wid * 16 + l15) * 128 + vt * 16 + lq * 4)) = C[vt];
        }
    }
    __syncthreads();
}

__device__ void mixer_unit(const Params& p, int layer, int kind, int v, bool sample, LAS unsigned char* lds) {
    if (kind == 0) rwkv_scan(p, layer, v >> 4, (v >> 1) & 7, v & 1, sample, lds);
    if (kind == 1) chunk_unit<0>(p, layer, v >> 3, v & 7, sample, lds);
    if (kind == 2) chunk_unit<1>(p, layer, v >> 2, v & 3, sample, lds);
}
__device__ void mixer_phase(const Params& p, int layer, LAS unsigned char* lds, int bid, int nb) {
    constexpr int NLONG = 224, NSMALL = 896;
    if (nb >= NLONG + 8) {
#ifndef PROBE_UNIT
#define PROBE_UNIT -1
#endif
        if (bid < NLONG) { const int kind_ = bid < 128 ? 0 : (bid < 192 ? 1 : 2); const int nrep_ = PROBE_UNIT == kind_ ? 2 : 1;
#pragma unroll 1
            for (int rep_ = 0; rep_ < nrep_; ++rep_) mixer_unit(p, layer, kind_, bid < 128 ? bid : (bid < 192 ? bid - 128 : bid - 192), false, lds); }
        unsigned* ctr = (unsigned*)(p.ws + WS_CTR) + layer;
        LAS unsigned* slot = (LAS unsigned*)(lds + LDS_BYTES - 16);
        for (;;) {
            __syncthreads();
            if (fresh_tid() == 0) *slot = atomicAdd(ctr, 1u);
            __syncthreads();
            const unsigned u = *slot;
            if (u >= (unsigned)NSMALL) break;
            if (u < 256) mixer_unit(p, layer, 1, (int)u, true, lds); else if (u < 384) mixer_unit(p, layer, 2, (int)u - 256, true, lds); else mixer_unit(p, layer, 0, (int)u - 384, true, lds);
        }
    } else {
        for (int u = bid; u < NLONG + NSMALL; u += nb) {
            if (u < 128) mixer_unit(p, layer, 0, u, false, lds); else if (u < 192) mixer_unit(p, layer, 1, u - 128, false, lds); else if (u < 224) mixer_unit(p, layer, 2, u - 192, false, lds);
            else if (u < 480) mixer_unit(p, layer, 1, u - 224, true, lds); else if (u < 608) mixer_unit(p, layer, 2, u - 480, true, lds); else mixer_unit(p, layer, 0, u - 608, true, lds);
        }
    }
}

__global__ void __launch_bounds__(NTHREADS, 2) fwd_kernel(Params p) {
    extern __shared__ __attribute__((aligned(16))) unsigned char shm_[];
    LAS unsigned char* lds = (LAS unsigned char*)shm_;
    const int nb = gridDim.x;
    bf16_t* WTIN = (bf16_t*)(p.ws + WS_WTIN);
    bf16_t* BUFA = (bf16_t*)(p.ws + WS_BUFA); bf16_t* BUFB = (bf16_t*)(p.ws + WS_BUFB); bf16_t* PB = (bf16_t*)(p.ws + WS_P);
#ifndef PROBE_SUB
#define PROBE_SUB -1
#endif
    for (int ph = p.ph_lo; ph < p.ph_hi; ++ph) {
      const int nrep = (PROBE_SUB >= 0 && ((ph == 0 && PROBE_SUB == 7) || (ph > 0 && (ph - 1) % 7 == PROBE_SUB))) ? 2 : 1;
#pragma unroll 1
      for (int rep = 0; rep < nrep; ++rep) {
        int bid = blockIdx.x; asm volatile("" : "+s"(bid));
        if (ph == 0) {
#ifndef SKIP_CONV
            convert_T(p.in[11], 2048, NIN, NINP, WTIN, 2048, (LAS float*)lds, bid, nb);
            for (int l = 0; l < 2; ++l) {
                bf16_t* wl = (bf16_t*)(p.ws + WS_WTS + (size_t)l * WTS_LAYER);
                convert_T(p.in[27] + (size_t)l * 1024 * 2048, 1024, 2048, 2048, wl, 2048, (LAS float*)lds, bid, nb);
                convert_T(p.in[28] + (size_t)l * 512 * 2048, 512, 2048, 2048, wl + 1024, 2048, (LAS float*)lds, bid, nb);
                convert_T(p.in[29] + (size_t)l * 512 * 2048, 512, 2048, 2048, wl + 1536, 2048, (LAS float*)lds, bid, nb);
                convert_T(p.in[30] + (size_t)l * 2048 * 2048, 2048, 2048, 2048, wl + (size_t)2048 * 2048, 2048, (LAS float*)lds, bid, nb);
            }
#endif
#ifndef SKIP_NORM
            prenorm0(p, bid, nb);
#endif
        } else {
            const int layer = (ph - 1) / 7, sub = (ph - 1) % 7;
            bf16_t* wl = (bf16_t*)(p.ws + WS_WTS + (size_t)layer * WTS_LAYER);
            if (sub == 0) {
                pg8::Gemm g{BUFA, WTIN, MPAD, NINP, 2048}; pg8::StaticOrder S; S.init(MPAD, NINP, nb, bid);
                pg8::EpiStoreT<true> E{PB, NINP};
                pg8::gemm_phase(lds, g, S, E);
            } else if (sub == 1) {
#ifndef SKIP_PREP
                rwkv_prep(p, layer, lds, bid, nb);
#endif
            } else if (sub == 2) {
#ifndef SKIP_MIX
                mixer_phase(p, layer, lds, bid, nb);
#endif
            } else if (sub == 3) {
                rwkv_post(p, layer, bid, nb);
            } else if (sub == 4) {
                pg8::Gemm g{BUFB, wl, MPAD, 2048, 2048}; pg8::StaticOrder S; S.init(MPAD, 2048, nb, bid);
                pg8::EpiGate3 E{BUFA, PB + G_BASE};
                pg8::gemm_phase(lds, g, S, E);
            } else if (sub == 5) {
                pg8::Gemm g{BUFA, wl + (size_t)2048 * 2048, MPAD, 2048, 2048}; pg8::StaticOrder S; S.init(MPAD, 2048, nb, bid);
                pg8::EpiStoreT<false> E{BUFB, 2048};
                pg8::gemm_phase(lds, g, S, E);
            } else {
#ifndef SKIP_CONV
                if (layer == 0) convert_T(p.in[11] + (size_t)2048 * NIN, 2048, NIN, NINP, WTIN, 2048, (LAS float*)lds, bid, nb);
#endif
#ifndef SKIP_NORM
                postnorm(p, layer, bid, nb);
#endif
            }
        }
        if (ph + 1 < p.ph_hi || rep + 1 < nrep) { if (p.coop) cg::this_grid().sync(); }
      }
    }
}

extern "C" void kernel_launch(void* const* d_in, const int* in_sizes, int n_in, void* d_out, int out_size, void* d_ws, size_t ws_size, hipStream_t stream) {
    static int grid = 0;
    if (grid == 0) {
        if (n_in != 31 || ws_size < WS_END || (size_t)out_size != O_END) { fprintf(stderr, "kernel_launch: unexpected shapes: n_in %d out %d ws %zu (need %zu)\n", n_in, out_size, ws_size, (size_t)WS_END); grid = -1; return; }
        int dev = 0, cus = 0, per_cu = 0;
        hipGetDevice(&dev); hipDeviceGetAttribute(&cus, hipDeviceAttributeMultiprocessorCount, dev);
        if (hipFuncSetAttribute((const void*)fwd_kernel, hipFuncAttributeMaxDynamicSharedMemorySize, LDS_BYTES) != hipSuccess) { fprintf(stderr, "kernel_launch: hipFuncSetAttribute failed\n"); grid = -1; return; }
        if (hipOccupancyMaxActiveBlocksPerMultiprocessor(&per_cu, (const void*)fwd_kernel, NTHREADS, LDS_BYTES) != hipSuccess || per_cu < 1) { fprintf(stderr, "kernel_launch: occupancy query says %d\n", per_cu); per_cu = 1; }
        (void)hipGetLastError();
        grid = cus * per_cu;
    }
    if (grid < 0) return;
    if (hipMemsetAsync((char*)d_ws + WS_CTR, 0, 256, stream) != hipSuccess) { fprintf(stderr, "kernel_launch: memset failed\n"); return; }
    Params p{};
    for (int i = 0; i < 31; ++i) p.in[i] = (const float*)d_in[i];
    p.out = (float*)d_out; p.ws = (unsigned char*)d_ws; p.pad = 0;
#ifdef MULTI_LAUNCH
    p.coop = 0;
    for (int ph = 0; ph < 15; ++ph) { p.ph_lo = ph; p.ph_hi = ph + 1; hipLaunchKernelGGL(fwd_kernel, dim3(grid), dim3(NTHREADS), LDS_BYTES, stream, p); }
#else
    p.coop = 1; p.ph_lo = 0; p.ph_hi = 15;
    void* args[] = {&p};
    hipError_t e = hipLaunchCooperativeKernel((const void*)fwd_kernel, dim3(grid), dim3(NTHREADS), args, LDS_BYTES, stream);
    if (e != hipSuccess) fprintf(stderr, "cooperative launch failed: %s (grid %d)\n", hipGetErrorString(e), grid);
#endif
}
```

```cpp
#include <hip/hip_runtime.h>
#include <hip/hip_cooperative_groups.h>
#include <cstdio>
namespace cg = cooperative_groups;

#define LAS __attribute__((address_space(3)))
typedef unsigned short bf16_t;
typedef short bf16x8 __attribute__((ext_vector_type(8)));
typedef float f32x4 __attribute__((ext_vector_type(4)));
typedef float f32x2 __attribute__((ext_vector_type(2)));
typedef unsigned u32x4 __attribute__((ext_vector_type(4)));
typedef unsigned u32x2 __attribute__((ext_vector_type(2)));

constexpr int DM = 2048, MROWS = 18560, MPAD = 18688, NP_ROWS = 16512, TP = 2064;
constexpr int NIN = 15504, NINP = 15616;
constexpr int A_Q = 0, A_K = 1024, A_V = 2048, A_I = 3072, A_F = 3080, A_O = 3088, A_Z = 4112;
constexpr int B_Q = 5136, B_F = 5648, B_I = 6160, B_Z = 6672;
constexpr int C_BASE = 7184, C_COLS = 2176;
constexpr int CO_R = 0, CO_K = 512, CO_V = 1024, CO_WD = 1536, CO_AD = 1600, CO_Z = 1664;
constexpr int G_BASE = 9360;
constexpr int LDS_BYTES = 163840;
constexpr int NTHREADS = 512;

constexpr size_t O_YP = 0, O_YS = 33554432, O_CP = O_YS + 4194304, O_NP = O_CP + 2097152, O_MP = O_NP + 16384, O_HP = O_MP + 128,
                 O_RP = O_HP + 1048576, O_SHP = O_RP + 524288, O_CS = O_SHP + 34816, O_NS = O_CS + 8388608, O_MS = O_NS + 65536,
                 O_HS = O_MS + 512, O_RS = O_HS + 4194304, O_SHS = O_RS + 2097152, O_END = O_SHS + 139264;

constexpr size_t WS_WTIN = 0;
constexpr size_t WS_WTS = WS_WTIN + (size_t)NINP * 2048 * 2;
constexpr size_t WTS_LAYER = (size_t)2048 * 4096 * 2;
constexpr size_t WS_BUFA = WS_WTS + 2 * WTS_LAYER;
constexpr size_t BUF_BYTES = (size_t)MPAD * 2048 * 2;
constexpr size_t WS_BUFB = WS_BUFA + BUF_BYTES;
constexpr size_t WS_P = WS_BUFB + BUF_BYTES;
constexpr size_t WS_RX = WS_P + (size_t)MPAD * NINP * 2;
constexpr size_t RARR = (size_t)MPAD * 512 * 2;
constexpr size_t WS_XMETA = WS_RX + 4 * RARR;
constexpr size_t WS_YRAW = WS_XMETA + (size_t)8 * 16 * 2048 * 4;
constexpr size_t WS_CTR = WS_YRAW + (size_t)MPAD * 512 * 4;
constexpr size_t WS_XBAR = WS_CTR + 256;
constexpr size_t WS_LRT = WS_XBAR + 16384;
constexpr size_t WS_END = WS_LRT + 2 * 65536 * 2;

struct Params {
    const float* in[31];
    float* out;
    unsigned char* ws;
    int ph_lo, ph_hi, coop, pad;
};

__device__ __forceinline__ float bf2f(bf16_t x) { return __uint_as_float(((unsigned)x) << 16); }
__device__ __forceinline__ float bflo(unsigned w) { return __uint_as_float(w << 16); }
__device__ __forceinline__ float bfhi(unsigned w) { return __uint_as_float(w & 0xffff0000u); }
__device__ __forceinline__ bf16_t f2bf(float f) { unsigned u = __float_as_uint(f); u += 0x7FFFu + ((u >> 16) & 1u); return (bf16_t)(u >> 16); }
__device__ __forceinline__ unsigned pk2(float lo, float hi) { return (unsigned)f2bf(lo) | ((unsigned)f2bf(hi) << 16); }
__device__ __forceinline__ float sigmoidf_(float x) { return __builtin_amdgcn_rcpf(1.0f + __expf(-x)); }
__device__ __forceinline__ float logsigmoidf_(float x) { return fminf(x, 0.f) - __logf(1.0f + __expf(-fabsf(x))); }
__device__ __forceinline__ float wave_sum(float v) {
#pragma unroll
    for (int d = 32; d >= 1; d >>= 1) v += __shfl_xor(v, d);
    return v;
}
template <int CTRL> __device__ __forceinline__ float dppf(float v) { return __int_as_float(__builtin_amdgcn_update_dpp(0, __float_as_int(v), CTRL, 0xf, 0xf, true)); }
__device__ __forceinline__ float row16_sum(float v) {
    v += dppf<0xB1>(v); v += dppf<0x4E>(v); v += dppf<0x141>(v); v += dppf<0x140>(v); return v;
}

__device__ __forceinline__ int fresh_tid() { int t = threadIdx.x; asm volatile("" : "+v"(t)); return t; }
__device__ __forceinline__ float wave_sum_fast(float v) {
    v = row16_sum(v); const int iv = __float_as_int(v);
    return (__int_as_float(__builtin_amdgcn_readlane(iv, 0)) + __int_as_float(__builtin_amdgcn_readlane(iv, 16))) + (__int_as_float(__builtin_amdgcn_readlane(iv, 32)) + __int_as_float(__builtin_amdgcn_readlane(iv, 48)));
}
__device__ __forceinline__ const float* x0_row(const Params& p, int r) {
    if (r < NP_ROWS) { const int b = r / TP, t = r - b * TP; return t < 16 ? p.in[8] + (size_t)t * DM : p.in[0] + ((size_t)b * 2048 + (t - 16)) * DM; }
    return p.in[1] + (size_t)(r - NP_ROWS) * DM;
}
__device__ __forceinline__ float* x1_row(const Params& p, int r) {
    if (r < NP_ROWS) { const int b = r / TP, t = r - b * TP; return t < 16 ? (float*)(p.ws + WS_XMETA) + ((size_t)b * 16 + t) * DM : p.out + O_YP + ((size_t)b * 2048 + (t - 16)) * DM; }
    return p.out + O_YS + (size_t)(r - NP_ROWS) * DM;
}

namespace pg8 {
constexpr int BM = 256, BK = 64, HALF = 128, HTB = HALF * BK * 2, STAGE_BYTES = 8 * HTB, NXCD = 8, WGM = 8;
__device__ __forceinline__ int lds_byte(int r, int c) { const int st = (r >> 4) * 2 + (c >> 5), rr = r & 15, cc = c & 31, ob = rr * 64 + cc * 2; return st * 1024 + (ob ^ (((ob >> 9) & 1) << 5)); }
__device__ __forceinline__ void stage_rc(int b, int& R, int& C) { const int st = b / 1024, sb = b % 1024, swz = sb ^ (((sb >> 9) & 1) << 5); R = (st >> 1) * 16 + swz / 64; C = (st & 1) * 32 + (swz % 64) / 2; }
__device__ __forceinline__ int perm32(int rho) { const int n = rho >> 4, i = rho & 15; return 8 * (i >> 2) + 4 * n + (i & 3); }
struct Unit { int pm, pn; };
struct Gemm { const bf16_t* A; const bf16_t* Bt; int M, N, K; };
struct StaticOrder {
    int nM, nN, nwg, G, c;
    __device__ void init(int M, int N, int G_, int c_) { nM = M / BM; nN = N / BM; nwg = nM * nN; G = G_; c = c_; }
    __device__ bool next(int i, Unit& u) const {
        const long L = (long)i * G + c; if (L >= nwg) return false;
        int wgid = (int)L; { const int q = nwg / NXCD, r = nwg % NXCD, xcd = wgid % NXCD, off = wgid / NXCD; wgid = (xcd < r ? xcd * (q + 1) : r * (q + 1) + (xcd - r) * q) + off; }
        const int nig = WGM * nN, gid = wgid / nig, fm = gid * WGM, gsz = (nM - fm) < WGM ? (nM - fm) : WGM;
        u.pm = fm + ((wgid % nig) % gsz); u.pn = (wgid % nig) / gsz; return true;
    }
    __device__ __forceinline__ void a_ready(const Unit&) const {}
    __device__ __forceinline__ void done(const Unit&) const {}
};
__device__ __forceinline__ unsigned cvt_pk_bf16(float lo, float hi) { unsigned r; asm volatile("v_cvt_pk_bf16_f32 %0, %1, %2" : "=v"(r) : "v"(lo), "v"(hi)); return r; }

template <bool SIG> struct EpiStoreT {
    static constexpr bool PERM = true, HOOK = false;
    bf16_t* O; int ldc;
    __device__ __forceinline__ void mid(f32x4 (&acc)[2][2][4][2], const Unit& u, int wr, int wc, int fr, int fq, int which) const {}
    __device__ __forceinline__ void operator()(f32x4 (&acc)[2][2][4][2], const Unit& u, int wr, int wc, int fr, int fq) const {
        const int row0 = u.pm * BM + wr * 64 + fr, col0 = u.pn * BM + wc * 32 + 8 * fq;
#pragma unroll
        for (int bj = 0; bj < 2; ++bj) {
            const bool sg = SIG && (col0 + bj * HALF >= G_BASE);
#pragma unroll
            for (int ai = 0; ai < 2; ++ai)
#pragma unroll
                for (int m = 0; m < 4; ++m) { bf16_t* rowp = O + (size_t)(row0 + ai * HALF + m * 16) * ldc + col0;
                    f32x4 v0 = acc[ai][bj][m][0], v1 = acc[ai][bj][m][1];
                    if (sg) {
#pragma unroll
                        for (int j = 0; j < 4; ++j) { v0[j] = sigmoidf_(v0[j]); v1[j] = sigmoidf_(v1[j]); } }
                    u32x4 w; w.x = cvt_pk_bf16(v0[0], v0[1]); w.y = cvt_pk_bf16(v0[2], v0[3]); w.z = cvt_pk_bf16(v1[0], v1[1]); w.w = cvt_pk_bf16(v1[2], v1[3]);
                    *(u32x4*)(rowp + bj * HALF) = w; }
        }
    }
};
struct EpiGate3 {
    static constexpr bool PERM = true, HOOK = true; static constexpr int HB = 4;
    bf16_t* O; const bf16_t* SG;
    __device__ __forceinline__ void mid(f32x4 (&acc)[2][2][4][2], const Unit& u, int wr, int wc, int fr, int fq, int which) const {
        int row0 = u.pm * BM + wr * 64 + fr, col0 = u.pn * BM + wc * 32 + 8 * fq; asm volatile("" : "+v"(row0), "+v"(col0));
        const bf16_t* gn = SG + which * 2048; const bf16_t* gd = SG + (which + 1) * 2048;
#pragma unroll
        for (int ai = 0; ai < 2; ++ai)
#pragma unroll
            for (int mh = 0; mh < 4 / HB; ++mh) {
                u32x4 ga[HB][2], gb[HB][2];
#pragma unroll
                for (int mm = 0; mm < HB; ++mm) { const unsigned ro = (unsigned)(row0 + ai * HALF + (HB * mh + mm) * 16) * (unsigned)NINP + (unsigned)col0;
#pragma unroll
                    for (int bj = 0; bj < 2; ++bj) { ga[mm][bj] = *(const u32x4*)(gn + ro + bj * HALF); gb[mm][bj] = *(const u32x4*)(gd + ro + bj * HALF); } }
#pragma unroll
                for (int mm = 0; mm < HB; ++mm)
#pragma unroll
                    for (int bj = 0; bj < 2; ++bj) { const u32x4 a = ga[mm][bj], b = gb[mm][bj];
                        f32x4& v0 = acc[ai][bj][HB * mh + mm][0]; f32x4& v1 = acc[ai][bj][HB * mh + mm][1];
                        v0[0] *= bflo(a.x) * __builtin_amdgcn_rcpf(bflo(b.x)); v0[1] *= bfhi(a.x) * __builtin_amdgcn_rcpf(bfhi(b.x));
                        v0[2] *= bflo(a.y) * __builtin_amdgcn_rcpf(bflo(b.y)); v0[3] *= bfhi(a.y) * __builtin_amdgcn_rcpf(bfhi(b.y));
                        v1[0] *= bflo(a.z) * __builtin_amdgcn_rcpf(bflo(b.z)); v1[1] *= bfhi(a.z) * __builtin_amdgcn_rcpf(bfhi(b.z));
                        v1[2] *= bflo(a.w) * __builtin_amdgcn_rcpf(bflo(b.w)); v1[3] *= bfhi(a.w) * __builtin_amdgcn_rcpf(bfhi(b.w)); }
                asm volatile("" ::: "memory");
            }
    }
    __device__ __forceinline__ void operator()(f32x4 (&acc)[2][2][4][2], const Unit& u, int wr, int wc, int fr, int fq) const {
        int row0 = u.pm * BM + wr * 64 + fr, col0 = u.pn * BM + wc * 32 + 8 * fq; asm volatile("" : "+v"(row0), "+v"(col0));
        const bf16_t* gc = SG + 4096;
#pragma unroll
        for (int ai = 0; ai < 2; ++ai) {
            u32x4 g[4][2];
#pragma unroll
            for (int m = 0; m < 4; ++m)
#pragma unroll
                for (int bj = 0; bj < 2; ++bj) g[m][bj] = *(const u32x4*)(gc + (unsigned)(row0 + ai * HALF + m * 16) * (unsigned)NINP + col0 + bj * HALF);
#pragma unroll
            for (int m = 0; m < 4; ++m) { const unsigned rr = (unsigned)(row0 + ai * HALF + m * 16);
#pragma unroll
                for (int bj = 0; bj < 2; ++bj) { const f32x4 v0 = acc[ai][bj][m][0], v1 = acc[ai][bj][m][1]; const u32x4 gg = g[m][bj];
                    u32x4 w; w.x = cvt_pk_bf16(v0[0] * bflo(gg.x), v0[1] * bfhi(gg.x)); w.y = cvt_pk_bf16(v0[2] * bflo(gg.y), v0[3] * bfhi(gg.y));
                    w.z = cvt_pk_bf16(v1[0] * bflo(gg.z), v1[1] * bfhi(gg.z)); w.w = cvt_pk_bf16(v1[2] * bflo(gg.w), v1[3] * bfhi(gg.w));
                    *(u32x4*)(O + rr * (unsigned)DM + col0 + bj * HALF) = w; } }
            asm volatile("" ::: "memory");
        }
    }
};

template <class Epi, class Sched>
__device__ __forceinline__ void gemm_phase(LAS unsigned char* lds, const Gemm g, const Sched& S, const Epi& E) {
    const int tid = fresh_tid(), wid = __builtin_amdgcn_readfirstlane(tid >> 6), lane = tid & 63, wr = wid >> 2, wc = wid & 3, fr = lane & 15, fq = lane >> 4;
    const int K = g.K, nt = K / BK;
    unsigned voffA[2], voffB[2];
#pragma unroll
    for (int i = 0; i < 2; ++i) { int R, C; stage_rc(tid * 16 + i * 8192, R, C); const int Rb = Epi::PERM ? ((R & ~31) + perm32(R & 31)) : R;
        voffA[i] = (unsigned)(R * K + C) * 2u; voffB[i] = (unsigned)(Rb * K + C) * 2u; }
    const size_t kstep = (size_t)(BK * 2);
    const size_t hstep = (size_t)HALF * K * 2;
    const size_t tstep = 2 * hstep;
    const unsigned ldsw = (unsigned)wid * 1024u;
    const int aoff = lds_byte(wr * 64 + fr, fq * 8), boff = lds_byte(wc * 32 + fr, fq * 8);
#define PG8_SA(b, h) (((b) * 2 + (h)) * HTB)
#define PG8_SB(b, h) ((4 + (b) * 2 + (h)) * HTB)
#define PG8_STAGE(bufoff, gbase, voff) do { _Pragma("unroll") for (int _i = 0; _i < 2; ++_i) \
        __builtin_amdgcn_global_load_lds((const unsigned*)((const char*)(gbase) + (voff)[_i]), (LAS unsigned*)(lds + (bufoff) + ldsw + _i * 8192), 16, 0, 0); } while (0)
#define PG8_LDA(dst, b, h) do { _Pragma("unroll") for (int m = 0; m < 4; ++m) _Pragma("unroll") for (int k = 0; k < 2; ++k) dst[m][k] = *(const LAS bf16x8*)(lds + PG8_SA(b, h) + aoff + m * 2048 + k * 1024); } while (0)
#define PG8_LDB(dst, b, h) do { _Pragma("unroll") for (int n = 0; n < 2; ++n) _Pragma("unroll") for (int k = 0; k < 2; ++k) dst[n][k] = *(const LAS bf16x8*)(lds + PG8_SB(b, h) + boff + n * 2048 + k * 1024); } while (0)
#define PG8_MMA(ai, bj, At, Bt) do { __builtin_amdgcn_s_setprio(1); _Pragma("unroll") for (int m = 0; m < 4; ++m) _Pragma("unroll") for (int n = 0; n < 2; ++n) _Pragma("unroll") for (int k = 0; k < 2; ++k) \
        acc[ai][bj][m][n] = __builtin_amdgcn_mfma_f32_16x16x32_bf16(Bt[n][k], At[m][k], acc[ai][bj][m][n], 0, 0, 0); __builtin_amdgcn_s_setprio(0); } while (0)
#define PG8_WAIT_V(n) asm volatile("s_waitcnt vmcnt(" #n ")" ::: "memory")
#define PG8_WAIT_L(n) asm volatile("s_waitcnt lgkmcnt(" #n ")" ::: "memory")
#define PG8_BAR __builtin_amdgcn_s_barrier()
#define PG8_SCHED __builtin_amdgcn_sched_barrier(0)
    Unit cur, nxt; int ui = 0;
    if (!S.next(0, cur)) return;
    f32x4 acc[2][2][4][2];
#pragma unroll
    for (int a = 0; a < 2; ++a)
#pragma unroll
        for (int b = 0; b < 2; ++b)
#pragma unroll
            for (int m = 0; m < 4; ++m)
#pragma unroll
                for (int n = 0; n < 2; ++n) acc[a][b][m][n] = (f32x4){0.f, 0.f, 0.f, 0.f};
    bf16x8 At[4][2], B0[2][2], B1[2][2];
    const char* cA = (const char*)g.A + (size_t)cur.pm * tstep; const char* cB = (const char*)g.Bt + (size_t)cur.pn * tstep;
    S.a_ready(cur);
    PG8_STAGE(PG8_SB(0, 0), cB, voffB); PG8_STAGE(PG8_SA(0, 0), cA, voffA); PG8_STAGE(PG8_SB(0, 1), cB + hstep, voffB); PG8_STAGE(PG8_SA(0, 1), cA + hstep, voffA);
    if (wr == 1) PG8_BAR;
    PG8_WAIT_V(4); PG8_BAR;
    PG8_STAGE(PG8_SB(1, 0), cB + kstep, voffB); PG8_STAGE(PG8_SA(1, 0), cA + kstep, voffA); PG8_STAGE(PG8_SB(1, 1), cB + hstep + kstep, voffB);
    PG8_WAIT_V(6); PG8_BAR;
    for (;;) {
        const bool has_next = S.next(ui + 1, nxt);
        const char* nA = has_next ? (const char*)g.A + (size_t)nxt.pm * tstep : cA; const char* nB = has_next ? (const char*)g.Bt + (size_t)nxt.pn * tstep : cB;
        for (int t = 0; t < nt; t += 2) {
            const bool last = (t == nt - 2);
            const char* a1 = cA + (size_t)(t + 1) * kstep;
            const char* a2 = last ? nA : cA + (size_t)(t + 2) * kstep; const char* b2 = last ? nB : cB + (size_t)(t + 2) * kstep;
            const char* a3 = a2 + kstep; const char* b3 = b2 + kstep;
            if (last && has_next) S.a_ready(nxt);
            if (Epi::HOOK && (t == 16 || t == 24)) E.mid(acc, cur, wr, wc, fr, fq, t == 16 ? 0 : 1);
            PG8_LDB(B0, 0, 0); PG8_SCHED; PG8_LDA(At, 0, 0); PG8_STAGE(PG8_SA(1, 1), a1 + hstep, voffA);
            PG8_WAIT_L(8); PG8_BAR; PG8_WAIT_L(0); PG8_MMA(0, 0, At, B0); PG8_BAR; PG8_SCHED;
            PG8_LDB(B1, 0, 1); PG8_STAGE(PG8_SB(0, 0), b2, voffB);
            PG8_BAR; PG8_WAIT_L(0); PG8_MMA(0, 1, At, B1); PG8_BAR;
            PG8_LDA(At, 0, 1); PG8_STAGE(PG8_SA(0, 0), a2, voffA);
            PG8_BAR; PG8_WAIT_L(0); PG8_MMA(1, 0, At, B0); PG8_BAR; PG8_SCHED;
            PG8_STAGE(PG8_SB(0, 1), b2 + hstep, voffB);
            PG8_WAIT_V(6); PG8_BAR; PG8_MMA(1, 1, At, B1); PG8_BAR;
            PG8_LDB(B0, 1, 0); PG8_SCHED; PG8_LDA(At, 1, 0); PG8_STAGE(PG8_SA(0, 1), a2 + hstep, voffA);
            PG8_WAIT_L(8); PG8_BAR; PG8_WAIT_L(0); PG8_MMA(0, 0, At, B0); PG8_BAR; PG8_SCHED;
            PG8_LDB(B1, 1, 1); PG8_STAGE(PG8_SB(1, 0), b3, voffB);
            PG8_BAR; PG8_WAIT_L(0); PG8_MMA(0, 1, At, B1); PG8_BAR;
            PG8_LDA(At, 1, 1); PG8_STAGE(PG8_SA(1, 0), a3, voffA);
            PG8_BAR; PG8_WAIT_L(0); PG8_MMA(1, 0, At, B0); PG8_BAR; PG8_SCHED;
            PG8_STAGE(PG8_SB(1, 1), b3 + hstep, voffB);
            PG8_WAIT_V(6); PG8_BAR; PG8_MMA(1, 1, At, B1); PG8_BAR;
        }
        E(acc, cur, wr, wc, fr, fq); S.done(cur);
        if (!has_next) break;
#pragma unroll
        for (int a = 0; a < 2; ++a)
#pragma unroll
            for (int b = 0; b < 2; ++b)
#pragma unroll
                for (int m = 0; m < 4; ++m)
#pragma unroll
                    for (int n = 0; n < 2; ++n) acc[a][b][m][n] = (f32x4){0.f, 0.f, 0.f, 0.f};
        cur = nxt; cA = nA; cB = nB; ++ui;
    }
    PG8_WAIT_V(0);
    if (wr == 0) PG8_BAR;
    PG8_BAR;
#undef PG8_SA
#undef PG8_SB
#undef PG8_STAGE
#undef PG8_LDA
#undef PG8_LDB
#undef PG8_MMA
#undef PG8_WAIT_V
#undef PG8_WAIT_L
#undef PG8_BAR
#undef PG8_SCHED
}
}

__device__ void convert_T(const float* __restrict__ W, int K, int N, int Npad, bf16_t* __restrict__ Wt, int ldw, LAS float* tile, int t0, int tstride) {
    const int tid = fresh_tid(), tk = K / 64, tn = Npad / 64, ntile = tk * tn;
    const int lk = tid >> 4, ln = (tid & 15) * 4;
    f32x4 v[2];
#define CT_LOAD(t) do { const int _k0 = ((t) % tk) * 64, _n0 = ((t) / tk) * 64; _Pragma("unroll") for (int _i = 0; _i < 2; ++_i) { v[_i] = (f32x4){0.f, 0.f, 0.f, 0.f}; \
        if (_n0 + ln < N) v[_i] = *(const f32x4*)(W + (size_t)(_k0 + lk + 32 * _i) * N + _n0 + ln); } } while (0)
    if (t0 < ntile) CT_LOAD(t0);
    for (int t = t0; t < ntile; t += tstride) {
        const int k0 = (t % tk) * 64, n0 = (t / tk) * 64;
#pragma unroll
        for (int i = 0; i < 2; ++i) { const int k = lk + 32 * i; tile[k * 65 + ln] = v[i][0]; tile[k * 65 + ln + 1] = v[i][1]; tile[k * 65 + ln + 2] = v[i][2]; tile[k * 65 + ln + 3] = v[i][3]; }
        __syncthreads();
        if (t + tstride < ntile) CT_LOAD(t + tstride);
        { const int n = tid >> 3, k8 = (tid & 7) * 8; u32x4 w;
          w.x = pk2(tile[(k8 + 0) * 65 + n], tile[(k8 + 1) * 65 + n]); w.y = pk2(tile[(k8 + 2) * 65 + n], tile[(k8 + 3) * 65 + n]);
          w.z = pk2(tile[(k8 + 4) * 65 + n], tile[(k8 + 5) * 65 + n]); w.w = pk2(tile[(k8 + 6) * 65 + n], tile[(k8 + 7) * 65 + n]);
          *(u32x4*)(Wt + (size_t)(n0 + n) * ldw + k0 + k8) = w; }
        __syncthreads();
    }
#undef CT_LOAD
}

__device__ void prenorm0(const Params& p, int bid, int nb) {
    const int tid_ = fresh_tid(); const int lane = tid_ & 63, wid = tid_ >> 6;
    bf16_t* H = (bf16_t*)(p.ws + WS_BUFA);
    const float* g = p.in[9];
    for (int r = bid * 8 + wid; r < MROWS; r += nb * 8) {
        const float* x = x0_row(p, r);
        f32x4 v[8]; float ss = 0.f;
#pragma unroll
        for (int i = 0; i < 8; ++i) { v[i] = *(const f32x4*)(x + i * 256 + lane * 4); ss += v[i][0] * v[i][0] + v[i][1] * v[i][1] + v[i][2] * v[i][2] + v[i][3] * v[i][3]; }
        ss = wave_sum(ss);
        const float rs = rsqrtf(ss * (1.0f / DM) + 1e-6f);
#pragma unroll
        for (int i = 0; i < 8; ++i) { const f32x4 gg = *(const f32x4*)(g + i * 256 + lane * 4);
            u32x2 w; w.x = pk2(v[i][0] * rs * gg[0], v[i][1] * rs * gg[1]); w.y = pk2(v[i][2] * rs * gg[2], v[i][3] * rs * gg[3]);
            *(u32x2*)(H + (size_t)r * DM + i * 256 + lane * 4) = w; }
    }
}
__device__ void postnorm(const Params& p, int layer, int bid, int nb) {
    const int tid_ = fresh_tid(); const int lane = tid_ & 63, wid = tid_ >> 6;
    const bf16_t* Y = (const bf16_t*)(p.ws + WS_BUFB);
    bf16_t* H = (bf16_t*)(p.ws + WS_BUFA);
    const float* gpost = p.in[10] + layer * DM;
    const float* gpre = p.in[9] + DM;
    for (int r = bid * 8 + wid; r < MROWS; r += nb * 8) {
        const float* x = layer == 0 ? x0_row(p, r) : x1_row(p, r);
        float* xo = x1_row(p, r);
        float yv[32]; float ss = 0.f;
#pragma unroll
        for (int i = 0; i < 4; ++i) { const u32x4 w = *(const u32x4*)(Y + (size_t)r * DM + i * 512 + lane * 8);
            yv[i * 8 + 0] = bflo(w.x); yv[i * 8 + 1] = bfhi(w.x); yv[i * 8 + 2] = bflo(w.y); yv[i * 8 + 3] = bfhi(w.y);
            yv[i * 8 + 4] = bflo(w.z); yv[i * 8 + 5] = bfhi(w.z); yv[i * 8 + 6] = bflo(w.w); yv[i * 8 + 7] = bfhi(w.w); }
#pragma unroll
        for (int i = 0; i < 32; ++i) ss += yv[i] * yv[i];
        ss = wave_sum(ss);
        const float rs = rsqrtf(ss * (1.0f / DM) + 1e-6f);
        float s2 = 0.f;
#pragma unroll
        for (int i = 0; i < 4; ++i)
#pragma unroll
            for (int h = 0; h < 2; ++h) { const int c = i * 512 + lane * 8 + h * 4;
                const f32x4 xv = *(const f32x4*)(x + c); const f32x4 gg = *(const f32x4*)(gpost + c);
                f32x4 o;
#pragma unroll
                for (int j = 0; j < 4; ++j) { o[j] = xv[j] + yv[i * 8 + h * 4 + j] * rs * gg[j]; s2 += o[j] * o[j]; yv[i * 8 + h * 4 + j] = o[j]; }
                *(f32x4*)(xo + c) = o; }
        if (layer == 0) {
            s2 = wave_sum(s2);
            const float r2 = rsqrtf(s2 * (1.0f / DM) + 1e-6f);
#pragma unroll
            for (int i = 0; i < 4; ++i) { const int c = i * 512 + lane * 8;
                const f32x4 g0 = *(const f32x4*)(gpre + c), g1 = *(const f32x4*)(gpre + c + 4);
                u32x4 w; w.x = pk2(yv[i * 8 + 0] * r2 * g0[0], yv[i * 8 + 1] * r2 * g0[1]); w.y = pk2(yv[i * 8 + 2] * r2 * g0[2], yv[i * 8 + 3] * r2 * g0[3]);
                w.z = pk2(yv[i * 8 + 4] * r2 * g1[0], yv[i * 8 + 5] * r2 * g1[1]); w.w = pk2(yv[i * 8 + 6] * r2 * g1[2], yv[i * 8 + 7] * r2 * g1[3]);
                *(u32x4*)(H + (size_t)r * DM + c) = w; }
        }
    }
}

__device__ __forceinline__ bf16_t* rarr(const Params& p, int i) { return (bf16_t*)(i < 4 ? p.ws + WS_BUFA + (size_t)i * RARR : p.ws + WS_RX + (size_t)(i - 4) * RARR); }
__device__ void rwkv_prep(const Params& p, int layer, LAS unsigned char* lds, int bid, int nb) {
    const int tid = fresh_tid(), lane = tid & 63, wid = __builtin_amdgcn_readfirstlane(tid >> 6), l15 = lane & 15, lq = lane >> 4;
    LAS bf16_t* PC = (LAS bf16_t*)lds;
    LAS bf16_t* XW = (LAS bf16_t*)(lds + 17 * C_COLS * 2);
    LAS bf16_t* XA = XW + 16 * 72;
    const bf16_t* P = (const bf16_t*)(p.ws + WS_P);
    const float* mu = p.in[17] + layer * C_COLS;
    const bf16_t* WT = (const bf16_t*)(p.ws + WS_LRT) + (size_t)layer * 65536;
    bf16x8 bw[4][2], ba[4][2];
    float w0c[4], a0c[4], kkc[4], kac[4], rkc[4], mur[4], muk[4], muv[4], muz[4];
#pragma unroll
    for (int ct = 0; ct < 4; ++ct) { const unsigned c = (unsigned)(wid * 64 + ct * 16 + l15);
#pragma unroll
        for (int ks = 0; ks < 2; ++ks) { bw[ct][ks] = *(const bf16x8*)(WT + c * 64 + ks * 32 + lq * 8); ba[ct][ks] = *(const bf16x8*)(WT + 32768 + c * 64 + ks * 32 + lq * 8); }
        w0c[ct] = (p.in[18] + layer * 512)[c]; a0c[ct] = (p.in[20] + layer * 512)[c]; kkc[ct] = (p.in[22] + layer * 512)[c]; kac[ct] = (p.in[23] + layer * 512)[c]; rkc[ct] = (p.in[24] + layer * 512)[c];
        mur[ct] = mu[CO_R + c]; muk[ct] = mu[CO_K + c]; muv[ct] = mu[CO_V + c]; muz[ct] = mu[CO_Z + c]; }
    bf16_t* oR = rarr(p, 0); bf16_t* oU = rarr(p, 1); bf16_t* oK = rarr(p, 2); bf16_t* oV = rarr(p, 3);
    bf16_t* oKK = rarr(p, 4); bf16_t* oKA = rarr(p, 5); bf16_t* oZS = rarr(p, 6); bf16_t* oBV = rarr(p, 7);
    for (int tile = bid; tile < MROWS / 16; tile += nb) {
        const int r0 = tile * 16;
        int seq_t0, seq_T, sb; bool sample;
        if (r0 < NP_ROWS) { sb = r0 / TP; seq_t0 = r0 - sb * TP; seq_T = TP; sample = false; } else { sb = (r0 - NP_ROWS) / 64; seq_t0 = (r0 - NP_ROWS) - sb * 64; seq_T = 64; sample = true; }
        {
            u32x4 buf[10];
#pragma unroll
            for (int it = 0; it < 10; ++it) { const int i = tid + it * NTHREADS; const int rr = i / (C_COLS / 8), cc = (i - rr * (C_COLS / 8)) * 8;
                u32x4 v = (u32x4){0u, 0u, 0u, 0u};
                if (i < 17 * (C_COLS / 8)) {
                    if (rr > 0 || seq_t0 > 0) v = *(const u32x4*)(P + (size_t)r0 * NINP + C_BASE + ((rr - 1) * NINP + cc));
                    else if (sample) { const float* sh = p.in[7] + ((size_t)layer * 32 + sb) * C_COLS + cc;
                        v.x = pk2(sh[0], sh[1]); v.y = pk2(sh[2], sh[3]); v.z = pk2(sh[4], sh[5]); v.w = pk2(sh[6], sh[7]); } }
                buf[it] = v; }
#pragma unroll
            for (int it = 0; it < 10; ++it) { const int i = tid + it * NTHREADS; if (i < 17 * (C_COLS / 8)) *(LAS u32x4*)(PC + i * 8) = buf[it]; }
        }
        __syncthreads();
#pragma unroll
        for (int it = 0; it < 4; ++it) { const int i = tid + it * NTHREADS; const int tok = i >> 7, j = i & 127, col = CO_WD + j;
            const float pc = bf2f(PC[(tok + 1) * C_COLS + col]), pv = bf2f(PC[tok * C_COLS + col]);
            const float xs = pc + mu[col] * (pv - pc);
            if (j < 64) { const float e = __expf(2.f * xs); XW[tok * 72 + j] = f2bf(1.f - 2.f * __builtin_amdgcn_rcpf(e + 1.f)); } else XA[tok * 72 + (j - 64)] = f2bf(xs); }
        if (seq_t0 + 16 == seq_T) { float* so = p.out + (sample ? O_SHS + ((size_t)layer * 32 + sb) * C_COLS : O_SHP + ((size_t)layer * 8 + sb) * C_COLS);
            for (int i = tid; i < C_COLS; i += NTHREADS) so[i] = bf2f(PC[16 * C_COLS + i]); }
        __syncthreads();
        f32x4 dw[4], da[4];
#pragma unroll
        for (int ct = 0; ct < 4; ++ct) { dw[ct] = (f32x4){0.f, 0.f, 0.f, 0.f}; da[ct] = (f32x4){0.f, 0.f, 0.f, 0.f}; }
#pragma unroll
        for (int ks = 0; ks < 2; ++ks) {
            const bf16x8 fw = *(const LAS bf16x8*)(XW + l15 * 72 + ks * 32 + lq * 8), fa = *(const LAS bf16x8*)(XA + l15 * 72 + ks * 32 + lq * 8);
#pragma unroll
            for (int ct = 0; ct < 4; ++ct) { dw[ct] = __builtin_amdgcn_mfma_f32_16x16x32_bf16(fw, bw[ct][ks], dw[ct], 0, 0, 0); da[ct] = __builtin_amdgcn_mfma_f32_16x16x32_bf16(fa, ba[ct][ks], da[ct], 0, 0, 0); }
        }
#pragma unroll
        for (int j = 0; j < 4; ++j) {
            const int t = lq * 4 + j;
            const LAS bf16_t* pc = PC + (t + 1) * C_COLS + wid * 64 + l15; const LAS bf16_t* pp = PC + t * C_COLS + wid * 64 + l15;
            float r[4], kt[4], v[4], zs[4], u[4], a[4], kk[4];
            float ss = 0.f, rk = 0.f;
#pragma unroll
            for (int ct = 0; ct < 4; ++ct) {
                float c_, q_;
                c_ = bf2f(pc[CO_R + ct * 16]); q_ = bf2f(pp[CO_R + ct * 16]); r[ct] = c_ + mur[ct] * (q_ - c_);
                c_ = bf2f(pc[CO_K + ct * 16]); q_ = bf2f(pp[CO_K + ct * 16]); const float k = c_ + muk[ct] * (q_ - c_);
                c_ = bf2f(pc[CO_V + ct * 16]); q_ = bf2f(pp[CO_V + ct * 16]); v[ct] = c_ + muv[ct] * (q_ - c_);
                c_ = bf2f(pc[CO_Z + ct * 16]); q_ = bf2f(pp[CO_Z + ct * 16]); const float z = c_ + muz[ct] * (q_ - c_);
                const float e = sigmoidf_(w0c[ct] + dw[ct][j]) * 0.60653066f;
                u[ct] = 1.f - __expf(-e);
                a[ct] = sigmoidf_(a0c[ct] + da[ct][j]);
                kk[ct] = k * kkc[ct]; ss += kk[ct] * kk[ct];
                kt[ct] = k * (1.f + (a[ct] - 1.f) * kac[ct]);
                rk += r[ct] * kt[ct] * rkc[ct];
                zs[ct] = z * sigmoidf_(z);
            }
            ss = row16_sum(ss); rk = row16_sum(rk);
            const float inv = __builtin_amdgcn_rsqf(fmaxf(ss, 1e-24f));
            const size_t ob = (size_t)(r0 + t) * 512 + wid * 64 + l15;
#pragma unroll
            for (int ct = 0; ct < 4; ++ct) { const size_t o = ob + ct * 16; const float kn = kk[ct] * inv;
                oR[o] = f2bf(r[ct]); oU[o] = f2bf(u[ct]); oK[o] = f2bf(kt[ct]); oV[o] = f2bf(v[ct]); oKK[o] = f2bf(kn); oKA[o] = f2bf(kn * a[ct]); oZS[o] = f2bf(zs[ct]); oBV[o] = f2bf(rk * v[ct] * zs[ct]); }
        }
        __syncthreads();
    }
}

__device__ void rwkv_scan(const Params& p, int layer, int bseq, int head, int half, bool sample, LAS unsigned char* lds) {
    const int tid = fresh_tid(), row = (tid >> 3) & 31, part = tid & 7;
    LAS float* LR = (LAS float*)lds;
    LAS float* LU = LR + 4096; LAS float* LK = LU + 4096; LAS float* LKK = LK + 4096; LAS float* LKA = LKK + 4096; LAS float* LV = LKA + 4096; LAS float* LY = LV + 4096;
    const int row_base = sample ? NP_ROWS + bseq * 64 : bseq * TP;
    const int T = sample ? 64 : TP;
    const int nch = (T + 63) / 64;
    const int vrow = half * 32 + row;
    f32x2 s0 = (f32x2){0.f, 0.f}, s1 = s0, s2 = s0, s3 = s0;
    if (sample) { const float* S = p.in[6] + ((((size_t)layer * 32 + bseq) * 8 + head) * 64) * 64;
        const f32x4 a = *(const f32x4*)(S + (unsigned)(vrow * 64 + part * 8)), b = *(const f32x4*)(S + (unsigned)(vrow * 64 + part * 8 + 4));
        s0 = (f32x2){a[0], a[1]}; s1 = (f32x2){a[2], a[3]}; s2 = (f32x2){b[0], b[1]}; s3 = (f32x2){b[2], b[3]}; }
    const int st = tid >> 3, sp = (tid & 7) * 8;
    const unsigned poff = (unsigned)(st * 512 + sp);
    u32x4 pf[6];
#define RW_PREFETCH(c) do { const int _t = (c) * 64 + st; if (_t < T) { const size_t _o = (size_t)(row_base + (c) * 64) * 512 + head * 64; \
        _Pragma("unroll") for (int _i = 0; _i < 6; ++_i) pf[_i] = *(const u32x4*)(rarr(p, _i) + _o + poff); } \
        else { _Pragma("unroll") for (int _i = 0; _i < 6; ++_i) pf[_i] = (u32x4){0u, 0u, 0u, 0u}; } } while (0)
    RW_PREFETCH(0);
    float* YR = (float*)(p.ws + WS_YRAW);
    for (int c = 0; c < nch; ++c) {
        const int L = (T - c * 64) < 64 ? (T - c * 64) : 64;
        {
            LAS float* dst[6] = {LR, LU, LK, LV, LKK, LKA};
#pragma unroll
            for (int i = 0; i < 6; ++i) { const u32x4 w = pf[i]; LAS float* d = dst[i] + st * 64 + sp;
                *(LAS f32x4*)d = (f32x4){bflo(w.x), bfhi(w.x), bflo(w.y), bfhi(w.y)}; *(LAS f32x4*)(d + 4) = (f32x4){bflo(w.z), bfhi(w.z), bflo(w.w), bfhi(w.w)}; }
        }
        __syncthreads();
        if (c + 1 < nch) RW_PREFETCH(c + 1);
        if (tid < 256) {
            const LAS float* qkk = LKK + part * 8; const LAS float* qu = LU + part * 8; const LAS float* qka = LKA + part * 8; const LAS float* qk = LK + part * 8; const LAS float* qr = LR + part * 8;
            const LAS float* qv = LV + vrow; LAS float* qy = LY + row;
#define RW_LD(dst, q, off) const f32x4 dst##a = *(const LAS f32x4*)((q) + (off)), dst##b = *(const LAS f32x4*)((q) + (off) + 4)
            f32x4 kka = *(const LAS f32x4*)qkk, kkb = *(const LAS f32x4*)(qkk + 4), ua = *(const LAS f32x4*)qu, ub = *(const LAS f32x4*)(qu + 4), kaa = *(const LAS f32x4*)qka, kab = *(const LAS f32x4*)(qka + 4);
            f32x4 ka_ = *(const LAS f32x4*)qk, kb_ = *(const LAS f32x4*)(qk + 4), ra = *(const LAS f32x4*)qr, rb = *(const LAS f32x4*)(qr + 4); float v = *qv; float ykeep = 0.f;
#pragma unroll 2
            for (int t = 0; t < L; ++t) {
                const int tn = (t + 1 < 64 ? t + 1 : 63) * 64;
                RW_LD(nkk, qkk, tn); RW_LD(nu, qu, tn); RW_LD(nka, qka, tn); RW_LD(nk, qk, tn); RW_LD(nr, qr, tn);
                const float nv = qv[tn];
                const f32x2 d2 = (s0 * (f32x2){kka[0], kka[1]} + s1 * (f32x2){kka[2], kka[3]}) + (s2 * (f32x2){kkb[0], kkb[1]} + s3 * (f32x2){kkb[2], kkb[3]});
                float d = d2[0] + d2[1]; d += dppf<0xB1>(d); d += dppf<0x4E>(d); d += dppf<0x141>(d);
                const f32x2 sa2 = (f32x2){-d, -d}, v2 = (f32x2){v, v};
                s0 = sa2 * (f32x2){kaa[0], kaa[1]} + (v2 * (f32x2){ka_[0], ka_[1]} + (s0 - s0 * (f32x2){ua[0], ua[1]}));
                s1 = sa2 * (f32x2){kaa[2], kaa[3]} + (v2 * (f32x2){ka_[2], ka_[3]} + (s1 - s1 * (f32x2){ua[2], ua[3]}));
                s2 = sa2 * (f32x2){kab[0], kab[1]} + (v2 * (f32x2){kb_[0], kb_[1]} + (s2 - s2 * (f32x2){ub[0], ub[1]}));
                s3 = sa2 * (f32x2){kab[2], kab[3]} + (v2 * (f32x2){kb_[2], kb_[3]} + (s3 - s3 * (f32x2){ub[2], ub[3]}));
                const f32x2 y2 = (s0 * (f32x2){ra[0], ra[1]} + s1 * (f32x2){ra[2], ra[3]}) + (s2 * (f32x2){rb[0], rb[1]} + s3 * (f32x2){rb[2], rb[3]});
                float y = y2[0] + y2[1]; y += dppf<0xB1>(y); y += dppf<0x4E>(y); y += dppf<0x141>(y);
                ykeep = ((t & 7) == part) ? y : ykeep;
                if ((t & 7) == 7) qy[(t - 7 + part) * 32] = ykeep;
                kka = nkka; kkb = nkkb; ua = nua; ub = nub; kaa = nkaa; kab = nkab; ka_ = nka; kb_ = nkb; ra = nra; rb = nrb; v = nv;
            }
#undef RW_LD
        }
        __syncthreads();
        { const int t = tid >> 3, r4 = (tid & 7) * 4;
          if (t < L) *(f32x4*)(YR + (size_t)(row_base + c * 64) * 512 + head * 64 + half * 32 + (unsigned)(t * 512 + r4)) = *(const LAS f32x4*)(LY + t * 32 + r4); }
        __syncthreads();
    }
#undef RW_PREFETCH
    if (tid < 256) { float* So = p.out + (sample ? O_RS + ((((size_t)layer * 32 + bseq) * 8 + head) * 64) * 64 : O_RP + ((((size_t)layer * 8 + bseq) * 8 + head) * 64) * 64);
      *(f32x4*)(So + (unsigned)(vrow * 64 + part * 8)) = (f32x4){s0[0], s0[1], s1[0], s1[1]}; *(f32x4*)(So + (unsigned)(vrow * 64 + part * 8 + 4)) = (f32x4){s2[0], s2[1], s3[0], s3[1]}; }
    __syncthreads();
}

__device__ void rwkv_post(const Params& p, int layer, int bid, int nb) {
    const int tid = fresh_tid(), lane = tid & 63, wid = tid >> 6;
    const float* YR = (const float*)(p.ws + WS_YRAW);
    const bf16_t* ZS = rarr(p, 6); const bf16_t* BV = rarr(p, 7);
    bf16_t* YC = (bf16_t*)(p.ws + WS_BUFB) + 1536;
    const float* gng = p.in[25] + layer * 512; const float* gnb = p.in[26] + layer * 512;
    const unsigned co = (unsigned)(lane * 8);
    const f32x4 g0 = *(const f32x4*)(gng + co), g1 = *(const f32x4*)(gng + co + 4), b0 = *(const f32x4*)(gnb + co), b1 = *(const f32x4*)(gnb + co + 4);
    const float gg[8] = {g0[0], g0[1], g0[2], g0[3], g1[0], g1[1], g1[2], g1[3]}, bb[8] = {b0[0], b0[1], b0[2], b0[3], b1[0], b1[1], b1[2], b1[3]};
    for (int r = bid * 8 + wid; r < MROWS; r += nb * 8) {
        const f32x4 ya = *(const f32x4*)(YR + (size_t)r * 512 + co), yb = *(const f32x4*)(YR + (size_t)r * 512 + co + 4);
        const u32x4 zs = *(const u32x4*)(ZS + (size_t)r * 512 + co), bv = *(const u32x4*)(BV + (size_t)r * 512 + co);
        float y[8] = {ya[0], ya[1], ya[2], ya[3], yb[0], yb[1], yb[2], yb[3]};
        float sm = 0.f;
#pragma unroll
        for (int j = 0; j < 8; ++j) sm += y[j];
        sm += dppf<0xB1>(sm); sm += dppf<0x4E>(sm); sm += dppf<0x141>(sm);
        const float mean = sm * (1.f / 64.f);
        float sv = 0.f;
#pragma unroll
        for (int j = 0; j < 8; ++j) { y[j] -= mean; sv += y[j] * y[j]; }
        sv += dppf<0xB1>(sv); sv += dppf<0x4E>(sv); sv += dppf<0x141>(sv);
        const float rstd = rsqrtf(sv * (1.f / 64.f) + 64e-5f);
        const float zz[8] = {bflo(zs.x), bfhi(zs.x), bflo(zs.y), bfhi(zs.y), bflo(zs.z), bfhi(zs.z), bflo(zs.w), bfhi(zs.w)};
        const float vv[8] = {bflo(bv.x), bfhi(bv.x), bflo(bv.y), bfhi(bv.y), bflo(bv.z), bfhi(bv.z), bflo(bv.w), bfhi(bv.w)};
        float o[8];
#pragma unroll
        for (int j = 0; j < 8; ++j) o[j] = (y[j] * rstd * gg[j] + bb[j]) * zz[j] + vv[j];
        u32x4 w; w.x = pk2(o[0], o[1]); w.y = pk2(o[2], o[3]); w.z = pk2(o[4], o[5]); w.w = pk2(o[6], o[7]);
        *(u32x4*)(YC + (size_t)r * 2048 + co) = w;
    }
}

constexpr int QS_LD = 136, VT_LD = 72, HO_LD = 132;
constexpr int L_QS = 0, L_KS = L_QS + 64 * QS_LD * 2, L_VT = L_KS + 64 * QS_LD * 2, L_KT = L_VT + 144 * VT_LD * 2, L_CB = L_KT + 128 * VT_LD * 2,
              L_SS = L_CB + 144 * QS_LD * 2, L_HO = L_SS + 64 * VT_LD * 2, L_GT = L_HO + 64 * HO_LD * 4, L_END = L_GT + 6144;
static_assert(L_END <= LDS_BYTES, "LDS overflow");
constexpr int G_B = 0, G_IG = 64, G_MT = 128, G_WI = 192, G_EMT = 256, G_WS = 320, G_DEN = 384, G_AMID = 448, G_AEND = 576, G_TOT = 704, G_LB = 1216, G_SC = 1344;

#define FRESH_IDS int T_ = threadIdx.x; asm volatile("" : "+v"(T_)); const int lane = T_ & 63; const int wid = __builtin_amdgcn_readfirstlane(T_ >> 6); \
    const int l15 = lane & 15, lq = lane >> 4, st = T_ >> 3, sp = (T_ & 7) * 16; (void)lane; (void)wid; (void)l15; (void)lq; (void)st; (void)sp;
template <int KIND>
__device__ void chunk_unit(const Params& p, int layer, int bseq, int head, bool sample, LAS unsigned char* lds) {
    constexpr int NVT = KIND == 0 ? 9 : 8;
    LAS bf16_t* QS = (LAS bf16_t*)(lds + L_QS); LAS bf16_t* KS = (LAS bf16_t*)(lds + L_KS); LAS bf16_t* VT = (LAS bf16_t*)(lds + L_VT);
    LAS bf16_t* KT = (LAS bf16_t*)(lds + L_KT); LAS bf16_t* CB = (LAS bf16_t*)(lds + L_CB); LAS bf16_t* SS = (LAS bf16_t*)(lds + L_SS);
    LAS float* HO = (LAS float*)(lds + L_HO); LAS float* GT = (LAS float*)(lds + L_GT);
    const bf16_t* P = (const bf16_t*)(p.ws + WS_P);
    const int cq = KIND == 0 ? A_Q + head * 128 : B_Q + head * 128;
    const int ck = KIND == 0 ? A_K + head * 128 : B_F + head * 128;
    const int cv = KIND == 0 ? A_V + head * 128 : B_I + head * 128;
    const int cz = KIND == 0 ? A_Z + head * 128 : B_Z + head * 128;
    const int co = A_O + head * 128;
    const int row_base = sample ? NP_ROWS + bseq * 64 : bseq * TP;
    const int nchunks = sample ? 1 : 33;
    const int NB = sample ? 32 : 8;

    f32x4 C[NVT];
#pragma unroll
    for (int vt = 0; vt < NVT; ++vt) C[vt] = (f32x4){0.f, 0.f, 0.f, 0.f};
    float m_run = 0.f;
    {
        FRESH_IDS
        if (sample) {
            if (KIND == 0) {
                const float* Cin = p.in[2] + ((((size_t)layer * 32 + bseq) * 8 + head) * 128) * 128;
#pragma unroll
                for (int vt = 0; vt < 8; ++vt)
#pragma unroll
                    for (int j = 0; j < 4; ++j) C[vt][j] = Cin[(unsigned)((vt * 16 + lq * 4 + j) * 128 + wid * 16 + l15)];
                if (lq == 0) C[NVT - 1][0] = (p.in[3] + (((size_t)layer * 32 + bseq) * 8 + head) * 128)[(unsigned)(wid * 16 + l15)];
                m_run = p.in[4][((size_t)layer * 32 + bseq) * 8 + head];
            } else {
                const float* Sin = p.in[5] + ((((size_t)layer * 32 + bseq) * 4 + head) * 128) * 128;
#pragma unroll
                for (int vt = 0; vt < 8; ++vt) C[vt] = *(const f32x4*)(Sin + (unsigned)((wid * 16 + l15) * 128 + vt * 16 + lq * 4));
            }
        }
        if (KIND == 0) { for (int i = T_; i < 16 * 64; i += NTHREADS) { const int rr = i >> 6, ss = i & 63; VT[(128 + rr) * VT_LD + ss] = rr == 0 ? (bf16_t)0x3F80 : (bf16_t)0; } }
        else if (T_ < 128) { float lb = 0.f; if (layer == 1) { const float l0 = p.in[15][head * 128 + T_], l1 = p.in[15][512 + head * 128 + T_]; lb = sigmoidf_(l1 - l0); } GT[G_LB + T_] = lb; }
    }
    const float b_i = KIND == 0 ? p.in[12][layer * 8 + head] : 0.f, b_f = KIND == 0 ? p.in[13][layer * 8 + head] : 0.f;

    float nw[16];
    { FRESH_IDS const float* nwb = (KIND == 0 ? p.in[14] + layer * 1024 : p.in[16] + layer * 512) + head * 128;
#pragma unroll
      for (int q = 0; q < 4; ++q) { const f32x4 x = *(const f32x4*)(nwb + (unsigned)(sp + q * 4)); nw[q * 4] = x[0]; nw[q * 4 + 1] = x[1]; nw[q * 4 + 2] = x[2]; nw[q * 4 + 3] = x[3]; } }
    u32x4 pq[2], pk[2], pv[2]; bf16_t pgi = 0, pgf = 0;
#define CU_PREFETCH(c) do { FRESH_IDS const int _t0 = sample ? 0 : ((c) == 0 ? 0 : 16 + 64 * ((c) - 1)); const int _L = (!sample && (c) == 0) ? 16 : 64; \
        const bf16_t* _r = P + (size_t)(row_base + _t0) * NINP; const unsigned toff = (unsigned)(st * NINP + sp); \
        if (st < _L) { \
            pq[0] = *(const u32x4*)(_r + cq + toff); pq[1] = *(const u32x4*)(_r + cq + 8 + toff); pk[0] = *(const u32x4*)(_r + ck + toff); pk[1] = *(const u32x4*)(_r + ck + 8 + toff); \
            pv[0] = *(const u32x4*)(_r + cv + toff); pv[1] = *(const u32x4*)(_r + cv + 8 + toff); } \
        else { pq[0] = pq[1] = pk[0] = pk[1] = pv[0] = pv[1] = (u32x4){0u, 0u, 0u, 0u}; } \
        if (KIND == 0 && T_ < 64) { if (T_ < _L) { const unsigned goff = (unsigned)(T_ * NINP); pgi = (_r + A_I + head)[goff]; pgf = (_r + A_F + head)[goff]; } } } while (0)
    CU_PREFETCH(0);
    if (KIND == 1) __syncthreads();

    for (int c = 0; c < nchunks; ++c) {
        const int t0 = sample ? 0 : (c == 0 ? 0 : 16 + 64 * (c - 1));
        const int L = (!sample && c == 0) ? 16 : 64;
        float qf[16], kf[16];
        {
            FRESH_IDS
            const unsigned qw[8] = {pq[0].x, pq[0].y, pq[0].z, pq[0].w, pq[1].x, pq[1].y, pq[1].z, pq[1].w};
            const unsigned kw[8] = {pk[0].x, pk[0].y, pk[0].z, pk[0].w, pk[1].x, pk[1].y, pk[1].z, pk[1].w};
            const unsigned vw[8] = {pv[0].x, pv[0].y, pv[0].z, pv[0].w, pv[1].x, pv[1].y, pv[1].z, pv[1].w};
            (void)qw;
            { LAS bf16_t* vtp = VT + sp * VT_LD + st;
#pragma unroll
              for (int j = 0; j < 8; ++j) { vtp[(2 * j) * VT_LD] = (bf16_t)(vw[j] & 0xffffu); vtp[(2 * j + 1) * VT_LD] = (bf16_t)(vw[j] >> 16); } }
            if (KIND == 0) {
                *(LAS u32x4*)(QS + st * QS_LD + sp) = pq[0]; *(LAS u32x4*)(QS + st * QS_LD + sp + 8) = pq[1];
                u32x4 k0, k1; const float sc = 0.08838834764831845f;
                k0.x = pk2(bflo(kw[0]) * sc, bfhi(kw[0]) * sc); k0.y = pk2(bflo(kw[1]) * sc, bfhi(kw[1]) * sc); k0.z = pk2(bflo(kw[2]) * sc, bfhi(kw[2]) * sc); k0.w = pk2(bflo(kw[3]) * sc, bfhi(kw[3]) * sc);
                k1.x = pk2(bflo(kw[4]) * sc, bfhi(kw[4]) * sc); k1.y = pk2(bflo(kw[5]) * sc, bfhi(kw[5]) * sc); k1.z = pk2(bflo(kw[6]) * sc, bfhi(kw[6]) * sc); k1.w = pk2(bflo(kw[7]) * sc, bfhi(kw[7]) * sc);
                *(LAS u32x4*)(KS + st * QS_LD + sp) = k0; *(LAS u32x4*)(KS + st * QS_LD + sp + 8) = k1;
                pk[0] = k0; pk[1] = k1;
                if (wid == 0) {
                    const float ig = lane < L ? bf2f(pgi) + b_i : -1e30f;
                    const float lf = lane < L ? logsigmoidf_(bf2f(pgf) + b_f) : 0.f;
                    float b = lf;
#pragma unroll
                    for (int d = 1; d < 64; d <<= 1) { const float y = __shfl_up(b, d); if (lane >= d) b += y; }
                    float pm = ig - b;
#pragma unroll
                    for (int d = 1; d < 64; d <<= 1) { const float y = __shfl_up(pm, d); if (lane >= d) pm = fmaxf(pm, y); }
                    const float b_end = __shfl(b, 63), pm_end = __shfl(pm, 63);
                    const float mt = b + fmaxf(m_run, pm);
                    const float m_new = b_end + fmaxf(m_run, pm_end);
                    GT[G_B + lane] = b; GT[G_IG + lane] = ig; GT[G_MT + lane] = mt; GT[G_WI + lane] = __expf(b + m_run - mt); GT[G_EMT + lane] = __expf(-mt);
                    GT[G_WS + lane] = __expf(b_end - b + ig - m_new);
                    if (lane == 0) { GT[G_SC + 0] = __expf(b_end + m_run - m_new); GT[G_SC + 1] = m_new; }
                }
                { LAS bf16_t* cbp = CB + (lq * 4) * QS_LD + wid * 16 + l15;
#pragma unroll
                  for (int vt = 0; vt < NVT; ++vt)
#pragma unroll
                    for (int j = 0; j < 4; ++j) cbp[(vt * 16 + j) * QS_LD] = f2bf(C[vt][j]); }
            } else {
#pragma unroll
                for (int j = 0; j < 8; ++j) {
#pragma unroll
                    for (int h = 0; h < 2; ++h) { const int e = 2 * j + h;
                        const float fp = h ? bfhi(kw[j]) : bflo(kw[j]); qf[e] = h ? bfhi(qw[j]) : bflo(qw[j]);
                        const float lb = GT[G_LB + sp + e]; const float sg = sigmoidf_(fp);
                        float lf = __logf(lb + (1.f - lb) * sg); float kk = (1.f - lb) * (1.f - sg);
                        if (st >= L) { lf = 0.f; kk = 0.f; }
                        kf[e] = kk; HO[st * HO_LD + sp + e] = lf; }
                }
            }
        }
        __syncthreads();
        float w_old = 1.f, m_new = 0.f;
        if (KIND == 0) {
            FRESH_IDS
            w_old = GT[G_SC + 0]; m_new = GT[G_SC + 1];
            const float wsv = GT[G_WS + st];
            const unsigned kw[8] = {pk[0].x, pk[0].y, pk[0].z, pk[0].w, pk[1].x, pk[1].y, pk[1].z, pk[1].w};
            LAS bf16_t* ktp = KT + sp * VT_LD + st;
#pragma unroll
            for (int j = 0; j < 8; ++j) { ktp[(2 * j) * VT_LD] = f2bf(bflo(kw[j]) * wsv); ktp[(2 * j + 1) * VT_LD] = f2bf(bfhi(kw[j]) * wsv); }
        } else {
            { FRESH_IDS const int k = T_ & 127, tg = T_ >> 7; float run = 0.f; LAS float* hp = HO + (tg * 16) * HO_LD + k;
#pragma unroll
              for (int i = 0; i < 16; ++i) { run += hp[i * HO_LD]; hp[i * HO_LD] = run; }
              GT[G_TOT + tg * 128 + k] = run; }
            __syncthreads();
            { FRESH_IDS const int k = T_ & 127, tg = T_ >> 7; float off = 0.f; LAS float* hp = HO + (tg * 16) * HO_LD + k;
              for (int g = 0; g < tg; ++g) off += GT[G_TOT + g * 128 + k];
              if (tg > 0) {
#pragma unroll
                  for (int i = 0; i < 16; ++i) hp[i * HO_LD] += off; }
              if (tg == 1) GT[G_AMID + k] = hp[15 * HO_LD];
              if (tg == 3) GT[G_AEND + k] = hp[15 * HO_LD]; }
            __syncthreads();
            {
                FRESH_IDS
                unsigned qa[8], kb[8];
                LAS bf16_t* ktp = KT + sp * VT_LD + st; LAS float* hp = HO + st * HO_LD + sp; LAS float* gm = GT + G_AMID + sp; LAS float* ge = GT + G_AEND + sp;
#pragma unroll
                for (int j = 0; j < 8; ++j) { float qv[2], kv[2];
#pragma unroll
                    for (int h = 0; h < 2; ++h) { const int e = 2 * j + h; const float a = hp[e], am = gm[e], ae = ge[e];
                        qv[h] = qf[e] * __expf(a - am); kv[h] = kf[e] * __expf(am - a);
                        ktp[e * VT_LD] = f2bf(kf[e] * __expf(ae - a)); }
                    qa[j] = pk2(qv[0], qv[1]); kb[j] = pk2(kv[0], kv[1]); }
                *(LAS u32x4*)(QS + st * QS_LD + sp) = (u32x4){qa[0], qa[1], qa[2], qa[3]}; *(LAS u32x4*)(QS + st * QS_LD + sp + 8) = (u32x4){qa[4], qa[5], qa[6], qa[7]};
                *(LAS u32x4*)(KS + st * QS_LD + sp) = (u32x4){kb[0], kb[1], kb[2], kb[3]}; *(LAS u32x4*)(KS + st * QS_LD + sp + 8) = (u32x4){kb[4], kb[5], kb[6], kb[7]};
                const float eam = __expf(GT[G_AMID + wid * 16 + l15]);
                LAS bf16_t* cbp = CB + (lq * 4) * QS_LD + wid * 16 + l15;
#pragma unroll
                for (int vt = 0; vt < NVT; ++vt)
#pragma unroll
                    for (int j = 0; j < 4; ++j) cbp[(vt * 16 + j) * QS_LD] = f2bf(C[vt][j] * eam);
            }
            __syncthreads();
        }
        u32x4 pz[2], po[2];
        { FRESH_IDS const bf16_t* r_ = P + (size_t)(row_base + t0) * NINP; const unsigned zo = st < L ? (unsigned)(st * NINP + sp) : (unsigned)sp;
          pz[0] = *(const u32x4*)(r_ + cz + zo); pz[1] = *(const u32x4*)(r_ + cz + 8 + zo);
          if (KIND == 0) { po[0] = *(const u32x4*)(r_ + co + zo); po[1] = *(const u32x4*)(r_ + co + 8 + zo); } }
        if (c + 1 < nchunks) CU_PREFETCH(c + 1);
        {
            FRESH_IDS
            const int ti = wid >> 1;
#pragma unroll
            for (int sjj = 0; sjj < 2; ++sjj) {
                const int sj = 2 * (wid & 1) + sjj;
                f32x4 a = (f32x4){0.f, 0.f, 0.f, 0.f};
                const LAS bf16_t* qp = QS + (ti * 16 + l15) * QS_LD + lq * 8; const LAS bf16_t* kp = KS + (sj * 16 + l15) * QS_LD + lq * 8;
#pragma unroll
                for (int kk = 0; kk < 4; ++kk) { const bf16x8 fa = *(const LAS bf16x8*)(qp + kk * 32); const bf16x8 fb = *(const LAS bf16x8*)(kp + kk * 32);
                    a = __builtin_amdgcn_mfma_f32_16x16x32_bf16(fa, fb, a, 0, 0, 0); }
                const int s = sj * 16 + l15;
                const float cs_ = KIND == 0 ? GT[G_IG + s] - GT[G_B + s] : 0.f;
                LAS bf16_t* ssp = SS + (ti * 16 + lq * 4) * VT_LD + s;
#pragma unroll
                for (int j = 0; j < 4; ++j) { const int t = ti * 16 + lq * 4 + j; float val;
                    if (KIND == 0) { const float arg = s <= t ? (GT[G_B + t] - GT[G_MT + t]) + cs_ : -1e30f; val = a[j] * __expf(arg); } else val = s <= t ? a[j] : 0.f;
                    ssp[j * VT_LD] = f2bf(val); }
            }
        }
        f32x4 hacc[5];
#pragma unroll
        for (int i = 0; i < 5; ++i) hacc[i] = (f32x4){0.f, 0.f, 0.f, 0.f};
        {
            FRESH_IDS
            const int hti = wid & 3, hv0 = (wid >> 2) * 4;
            const LAS bf16_t* qp = QS + (hti * 16 + l15) * QS_LD + lq * 8; const LAS bf16_t* cp = CB + (hv0 * 16 + l15) * QS_LD + lq * 8; const LAS bf16_t* cn = CB + (128 + l15) * QS_LD + lq * 8;
#pragma unroll
            for (int kk = 0; kk < 4; ++kk) {
                const bf16x8 fa = *(const LAS bf16x8*)(qp + kk * 32);
#pragma unroll
                for (int i = 0; i < 4; ++i) { const bf16x8 fb = *(const LAS bf16x8*)(cp + i * 16 * QS_LD + kk * 32); hacc[i] = __builtin_amdgcn_mfma_f32_16x16x32_bf16(fa, fb, hacc[i], 0, 0, 0); }
                if (KIND == 0 && wid < 4) { const bf16x8 fb = *(const LAS bf16x8*)(cn + kk * 32); hacc[4] = __builtin_amdgcn_mfma_f32_16x16x32_bf16(fa, fb, hacc[4], 0, 0, 0); }
                __builtin_amdgcn_sched_barrier(0);
            }
            if (KIND == 0) {
#pragma unroll
                for (int j = 0; j < 4; ++j) { const float wi = GT[G_WI + hti * 16 + lq * 4 + j];
#pragma unroll
                    for (int i = 0; i < 5; ++i) hacc[i][j] *= wi; }
            }
        }
        __syncthreads();
        {
            FRESH_IDS
            const int hti = wid & 3, hv0 = (wid >> 2) * 4;
            const LAS bf16_t* sp_ = SS + (hti * 16 + l15) * VT_LD + lq * 8; const LAS bf16_t* vp = VT + (hv0 * 16 + l15) * VT_LD + lq * 8; const LAS bf16_t* vn = VT + (128 + l15) * VT_LD + lq * 8;
#pragma unroll
            for (int kk = 0; kk < 2; ++kk) {
                const bf16x8 fa = *(const LAS bf16x8*)(sp_ + kk * 32);
#pragma unroll
                for (int i = 0; i < 4; ++i) { const bf16x8 fb = *(const LAS bf16x8*)(vp + i * 16 * VT_LD + kk * 32); hacc[i] = __builtin_amdgcn_mfma_f32_16x16x32_bf16(fa, fb, hacc[i], 0, 0, 0); }
                if (KIND == 0 && wid < 4) { const bf16x8 fb = *(const LAS bf16x8*)(vn + kk * 32); hacc[4] = __builtin_amdgcn_mfma_f32_16x16x32_bf16(fa, fb, hacc[4], 0, 0, 0); }
                __builtin_amdgcn_sched_barrier(0);
            }
            if (KIND == 0) {
                if (wid < 4 && l15 == 0) {
#pragma unroll
                    for (int j = 0; j < 4; ++j) GT[G_DEN + hti * 16 + lq * 4 + j] = hacc[4][j]; }
                __syncthreads();
                LAS float* hp = HO + (hti * 16 + lq * 4) * HO_LD + hv0 * 16 + l15;
#pragma unroll
                for (int j = 0; j < 4; ++j) { const int t = hti * 16 + lq * 4 + j; const float dn = __builtin_amdgcn_rcpf(fmaxf(fabsf(GT[G_DEN + t]), GT[G_EMT + t]));
#pragma unroll
                    for (int i = 0; i < 4; ++i) hp[j * HO_LD + i * 16] = hacc[i][j] * dn; }
            } else {
                LAS float* hp = HO + (hti * 16 + lq * 4) * HO_LD + hv0 * 16 + l15;
#pragma unroll
                for (int j = 0; j < 4; ++j) {
#pragma unroll
                    for (int i = 0; i < 4; ++i) hp[j * HO_LD + i * 16] = hacc[i][j]; }
            }
        }
        __syncthreads();
        {
            FRESH_IDS
            float hv[16];
#pragma unroll
            for (int q = 0; q < 4; ++q) { const f32x4 x = *(const LAS f32x4*)(HO + st * HO_LD + sp + q * 4); hv[q * 4] = x[0]; hv[q * 4 + 1] = x[1]; hv[q * 4 + 2] = x[2]; hv[q * 4 + 3] = x[3]; }
            float rs;
            if (KIND == 0) {
                float sm = 0.f;
#pragma unroll
                for (int j = 0; j < 16; ++j) sm += hv[j];
                sm += dppf<0xB1>(sm); sm += dppf<0x4E>(sm); sm += dppf<0x141>(sm);
                const float mean = sm * (1.f / 128.f); float sv = 0.f;
#pragma unroll
                for (int j = 0; j < 16; ++j) { hv[j] -= mean; sv += hv[j] * hv[j]; }
                sv += dppf<0xB1>(sv); sv += dppf<0x4E>(sv); sv += dppf<0x141>(sv);
                rs = rsqrtf(sv * (1.f / 128.f) + 1e-6f);
            } else {
                float sv = 0.f;
#pragma unroll
                for (int j = 0; j < 16; ++j) sv += hv[j] * hv[j];
                sv += dppf<0xB1>(sv); sv += dppf<0x4E>(sv); sv += dppf<0x141>(sv);
                rs = rsqrtf(sv * (1.f / 128.f) + 1e-6f);
            }
            const unsigned zw[8] = {pz[0].x, pz[0].y, pz[0].z, pz[0].w, pz[1].x, pz[1].y, pz[1].z, pz[1].w};
            unsigned ow[8] = {0, 0, 0, 0, 0, 0, 0, 0};
            if (KIND == 0) { ow[0] = po[0].x; ow[1] = po[0].y; ow[2] = po[0].z; ow[3] = po[0].w; ow[4] = po[1].x; ow[5] = po[1].y; ow[6] = po[1].z; ow[7] = po[1].w; }
            unsigned res[8];
#pragma unroll
            for (int j = 0; j < 8; ++j) { float o2[2];
#pragma unroll
                for (int h = 0; h < 2; ++h) { const int e = 2 * j + h; const float z = h ? bfhi(zw[j]) : bflo(zw[j]);
                    float o = hv[e] * rs * nw[e] * (z * sigmoidf_(z));
                    if (KIND == 0) { const float og = h ? bfhi(ow[j]) : bflo(ow[j]); o *= sigmoidf_(og); }
                    o2[h] = o; }
                res[j] = pk2(o2[0], o2[1]); }
            if (st < L) {
                bf16_t* Yb = (bf16_t*)(p.ws + WS_BUFB) + (size_t)(row_base + t0) * 2048 + (KIND == 0 ? 0 : 1024) + head * 128;
                const unsigned yo = (unsigned)(st * 2048 + sp);
                *(u32x4*)(Yb + yo) = (u32x4){res[0], res[1], res[2], res[3]}; *(u32x4*)(Yb + 8 + yo) = (u32x4){res[4], res[5], res[6], res[7]};
            }
        }
        {
            FRESH_IDS
            float csc = w_old;
            if (KIND == 1) csc = __expf(GT[G_AEND + wid * 16 + l15]);
#pragma unroll
            for (int vt = 0; vt < NVT; ++vt) C[vt] *= csc;
            const LAS bf16_t* kp = KT + (wid * 16 + l15) * VT_LD + lq * 8; const LAS bf16_t* vp = VT + l15 * VT_LD + lq * 8;
#pragma unroll
            for (int kk = 0; kk < 2; ++kk) {
                const bf16x8 fb = *(const LAS bf16x8*)(kp + kk * 32);
#pragma unroll
                for (int vt = 0; vt < NVT; ++vt) { const bf16x8 fa = *(const LAS bf16x8*)(vp + vt * 16 * VT_LD + kk * 32); C[vt] = __builtin_amdgcn_mfma_f32_16x16x32_bf16(fa, fb, C[vt], 0, 0, 0); }
                __builtin_amdgcn_sched_barrier(0);
            }
            m_run = m_new;
        }
        __syncthreads();
    }
#undef CU_PREFETCH
    {
        FRESH_IDS
        if (KIND == 0) {
            float* Co = p.out + (sample ? O_CS : O_CP) + ((((size_t)layer * NB + bseq) * 8 + head) * 128) * 128;
#pragma unroll
            for (int vt = 0; vt < 8; ++vt)
#pragma unroll
                for (int j = 0; j < 4; ++j) Co[(unsigned)((vt * 16 + lq * 4 + j) * 128 + wid * 16 + l15)] = C[vt][j];
            if (lq == 0) (p.out + (sample ? O_NS : O_NP) + (((size_t)layer * NB + bseq) * 8 + head) * 128)[(unsigned)(wid * 16 + l15)] = C[NVT - 1][0];
            if (T_ == 0) p.out[(sample ? O_MS : O_MP) + ((size_t)layer * NB + bseq) * 8 + head] = m_run;
        } else {
            float* So = p.out + (sample ? O_HS : O_HP) + ((((size_t)layer * NB + bseq) * 4 + head) * 128) * 128;
#pragma unroll
            for (int vt = 0; vt < 8; ++vt) *(f32x4*)(So + (unsigned)((wid * 16 + l15) * 128 + vt * 16 + lq * 4)) = C[vt];
        }
    }
    __syncthreads();
}

__device__ void mixer_unit(const Params& p, int layer, int kind, int v, bool sample, LAS unsigned char* lds) {
    if (kind == 0) rwkv_scan(p, layer, v >> 4, (v >> 1) & 7, v & 1, sample, lds);
    if (kind == 1) chunk_unit<0>(p, layer, v >> 3, v & 7, sample, lds);
    if (kind == 2) chunk_unit<1>(p, layer, v >> 2, v & 3, sample, lds);
}
__device__ void mixer_phase(const Params& p, int layer, LAS unsigned char* lds, int bid, int nb) {
    constexpr int NLONG = 224, NSMALL = 896;
    if (nb >= NLONG + 8) {
#ifndef PROBE_UNIT
#define PROBE_UNIT -1
#endif
        if (bid < NLONG) { const int kind_ = bid < 128 ? 0 : (bid < 192 ? 1 : 2); const int nrep_ = PROBE_UNIT == kind_ ? 2 : 1;
#pragma unroll 1
            for (int rep_ = 0; rep_ < nrep_; ++rep_) mixer_unit(p, layer, kind_, bid < 128 ? bid : (bid < 192 ? bid - 128 : bid - 192), false, lds); }
        unsigned* ctr = (unsigned*)(p.ws + WS_CTR) + layer;
        LAS unsigned* slot = (LAS unsigned*)(lds + LDS_BYTES - 16);
        for (;;) {
            __syncthreads();
            if (fresh_tid() == 0) *slot = atomicAdd(ctr, 1u);
            __syncthreads();
            const unsigned u = *slot;
            if (u >= (unsigned)NSMALL) break;
            if (u < 256) mixer_unit(p, layer, 1, (int)u, true, lds); else if (u < 384) mixer_unit(p, layer, 2, (int)u - 256, true, lds); else mixer_unit(p, layer, 0, (int)u - 384, true, lds);
        }
    } else {
        for (int u = bid; u < NLONG + NSMALL; u += nb) {
            if (u < 128) mixer_unit(p, layer, 0, u, false, lds); else if (u < 192) mixer_unit(p, layer, 1, u - 128, false, lds); else if (u < 224) mixer_unit(p, layer, 2, u - 192, false, lds);
            else if (u < 480) mixer_unit(p, layer, 1, u - 224, true, lds); else if (u < 608) mixer_unit(p, layer, 2, u - 480, true, lds); else mixer_unit(p, layer, 0, u - 608, true, lds);
        }
    }
}

#define XB_TMO      128
#define XB_XCNT(j)  (256  + 64 * (j))
#define XB_XSUB(j)  (1280 + 64 * (j))
#define XB_XGEN(j)  (2304 + 64 * (j))
#define XB_TOP      3328
#define XB_TOPGEN   3392
#define XCD_BAR_WORDS 3456
#define XB_SPIN_CAP (1u << 18)
__device__ __forceinline__ unsigned xb_ld(unsigned* p)              { return __hip_atomic_load(p, __ATOMIC_RELAXED, __HIP_MEMORY_SCOPE_AGENT); }
__device__ __forceinline__ unsigned xb_add(unsigned* p, unsigned v) { return __hip_atomic_fetch_add(p, v, __ATOMIC_RELAXED, __HIP_MEMORY_SCOPE_AGENT); }
__device__ __forceinline__ unsigned xb_xcc_id() { return (unsigned)__builtin_amdgcn_s_getreg((3 << 11) | 20) & 0xFu; }
#define XB_SPIN(cond, bar) do { unsigned _sp = 0; while (cond) { __builtin_amdgcn_s_sleep(1); \
    if ((++_sp & 255u) == 0u) { if (xb_ld(&(bar)[XB_TMO])) break; if (_sp > XB_SPIN_CAP) { atomicAdd(&(bar)[XB_TMO], 1u); break; } } } } while (0)
struct XcdBarrier { unsigned* bar; unsigned x; volatile LAS unsigned* st; };
__device__ __forceinline__ XcdBarrier xcd_barrier_post(unsigned* bar, volatile LAS unsigned* st) {
    XcdBarrier b; b.bar = bar; b.x = xb_xcc_id(); b.st = st;
    if (threadIdx.x == 0) (void)xb_add(&bar[XB_XCNT(b.x)], 1u);
    return b;
}
__device__ __forceinline__ void xcd_barrier_complete(unsigned* bar, unsigned x, unsigned& nloc, unsigned& nx) {
    const unsigned G = gridDim.x * gridDim.y * gridDim.z;
    unsigned sum, cnt, mine, sp = 0u;
    for (;;) {
        sum = 0u; cnt = 0u; mine = 0u;
#pragma unroll
        for (unsigned j = 0; j < 16; ++j) { const unsigned c = xb_ld(&bar[XB_XCNT(j)]); sum += c; cnt += (c > 0u) ? 1u : 0u; mine = (j == x) ? c : mine; }
        if (sum == G) break;
        __builtin_amdgcn_s_sleep(1);
        if ((++sp & 255u) == 0u) { if (xb_ld(&bar[XB_TMO])) break; if (sp > XB_SPIN_CAP) { atomicAdd(&bar[XB_TMO], 1u); break; } }
    }
    nloc = mine > 0u ? mine : 1u; nx = cnt > 0u ? cnt : 1u;
}
__device__ __forceinline__ void xcd_barrier(const XcdBarrier& b) {
    asm volatile("s_waitcnt vmcnt(0)" ::: "memory");
    __syncthreads();
    if (threadIdx.x == 0) {
        unsigned* bar = b.bar;
        __builtin_amdgcn_s_waitcnt(0);
        unsigned nloc = b.st[0], nx = b.st[1];
        if (nloc == 0u) { xcd_barrier_complete(bar, b.x, nloc, nx); b.st[0] = nloc; b.st[1] = nx; }
        const unsigned old = xb_add(&bar[XB_XSUB(b.x)], 1u);
        const unsigned gen = old / nloc;
        if (old + 1u == (gen + 1u) * nloc) {
            __builtin_amdgcn_fence(__ATOMIC_RELEASE, "agent");
            asm volatile("s_waitcnt vmcnt(0)" ::: "memory");
            const unsigned og = xb_add(&bar[XB_TOP], 1u);
            const unsigned tg = og / nx;
            if (og + 1u == (tg + 1u) * nx) xb_add(&bar[XB_TOPGEN], 1u);
            else XB_SPIN(xb_ld(&bar[XB_TOPGEN]) == tg, bar);
            __builtin_amdgcn_fence(__ATOMIC_ACQUIRE, "agent");
            xb_add(&bar[XB_XGEN(b.x)], 1u);
            asm volatile("s_waitcnt vmcnt(0)" ::: "memory");
        } else {
            XB_SPIN(xb_ld(&bar[XB_XGEN(b.x)]) == gen, bar);
            __builtin_amdgcn_fence(__ATOMIC_ACQUIRE, "agent");
            asm volatile("s_waitcnt vmcnt(0)" ::: "memory");
        }
    }
    __syncthreads();
}

__global__ void __launch_bounds__(NTHREADS, 2) fwd_kernel(Params p) {
    extern __shared__ __attribute__((aligned(16))) unsigned char shm_[];
    LAS unsigned char* lds = (LAS unsigned char*)shm_;
    const int nb = gridDim.x;
    volatile LAS unsigned* xst = (volatile LAS unsigned*)(lds + LDS_BYTES - 32);
    if (threadIdx.x == 0) { xst[0] = 0u; xst[1] = 0u; }
    __syncthreads();
    XcdBarrier xb = xcd_barrier_post((unsigned*)(p.ws + WS_XBAR), xst);
    bf16_t* WTIN = (bf16_t*)(p.ws + WS_WTIN);
    bf16_t* BUFA = (bf16_t*)(p.ws + WS_BUFA); bf16_t* BUFB = (bf16_t*)(p.ws + WS_BUFB); bf16_t* PB = (bf16_t*)(p.ws + WS_P);
#ifndef PROBE_SUB
#define PROBE_SUB -1
#endif
    for (int ph = p.ph_lo; ph < p.ph_hi; ++ph) {
      const int nrep = (PROBE_SUB >= 0 && ((ph == 0 && PROBE_SUB == 7) || (ph > 0 && (ph - 1) % 7 == PROBE_SUB))) ? 2 : 1;
#pragma unroll 1
      for (int rep = 0; rep < nrep; ++rep) {
        int bid = blockIdx.x; asm volatile("" : "+s"(bid));
        if (ph == 0) {
#ifndef SKIP_CONV
            convert_T(p.in[11], 2048, NIN, NINP, WTIN, 2048, (LAS float*)lds, bid, nb);
            for (int l = 0; l < 2; ++l) {
                bf16_t* wl = (bf16_t*)(p.ws + WS_WTS + (size_t)l * WTS_LAYER);
                convert_T(p.in[27] + (size_t)l * 1024 * 2048, 1024, 2048, 2048, wl, 2048, (LAS float*)lds, bid, nb);
                convert_T(p.in[28] + (size_t)l * 512 * 2048, 512, 2048, 2048, wl + 1024, 2048, (LAS float*)lds, bid, nb);
                convert_T(p.in[29] + (size_t)l * 512 * 2048, 512, 2048, 2048, wl + 1536, 2048, (LAS float*)lds, bid, nb);
                convert_T(p.in[30] + (size_t)l * 2048 * 2048, 2048, 2048, 2048, wl + (size_t)2048 * 2048, 2048, (LAS float*)lds, bid, nb);
            }
#endif
            { bf16_t* lrt = (bf16_t*)(p.ws + WS_LRT); const int t_ = fresh_tid(); int step_ = nb * NTHREADS; asm volatile("" : "+s"(step_));
#pragma unroll 1
              for (int i = bid * NTHREADS + t_; i < 4 * 32768; i += step_) { const int l = i >> 16, m = (i >> 15) & 1, c = (i >> 6) & 511, j = i & 63;
                  lrt[i] = f2bf(((m ? p.in[21] : p.in[19]) + (size_t)l * 32768)[j * 512 + c]); } }
#ifndef SKIP_NORM
            prenorm0(p, bid, nb);
#endif
        } else {
            const int layer = (ph - 1) / 7, sub = (ph - 1) % 7;
            bf16_t* wl = (bf16_t*)(p.ws + WS_WTS + (size_t)layer * WTS_LAYER);
            if (sub == 0) {
                pg8::Gemm g{BUFA, WTIN, MPAD, NINP, 2048}; pg8::StaticOrder S; S.init(MPAD, NINP, nb, bid);
                pg8::EpiStoreT<true> E{PB, NINP};
                pg8::gemm_phase(lds, g, S, E);
            } else if (sub == 1) {
#ifndef SKIP_PREP
                rwkv_prep(p, layer, lds, bid, nb);
#endif
            } else if (sub == 2) {
#ifndef SKIP_MIX
                mixer_phase(p, layer, lds, bid, nb);
#endif
            } else if (sub == 3) {
                rwkv_post(p, layer, bid, nb);
            } else if (sub == 4) {
                pg8::Gemm g{BUFB, wl, MPAD, 2048, 2048}; pg8::StaticOrder S; S.init(MPAD, 2048, nb, bid);
                pg8::EpiGate3 E{BUFA, PB + G_BASE};
                pg8::gemm_phase(lds, g, S, E);
            } else if (sub == 5) {
                pg8::Gemm g{BUFA, wl + (size_t)2048 * 2048, MPAD, 2048, 2048}; pg8::StaticOrder S; S.init(MPAD, 2048, nb, bid);
                pg8::EpiStoreT<false> E{BUFB, 2048};
                pg8::gemm_phase(lds, g, S, E);
            } else {
#ifndef SKIP_CONV
                if (layer == 0) convert_T(p.in[11] + (size_t)2048 * NIN, 2048, NIN, NINP, WTIN, 2048, (LAS float*)lds, bid, nb);
#endif
#ifndef SKIP_NORM
                postnorm(p, layer, bid, nb);
#endif
            }
        }
        if (ph + 1 < p.ph_hi || rep + 1 < nrep) { if (p.coop) { if (ph == 0 && rep == 0) cg::this_grid().sync(); else xcd_barrier(xb); } }
      }
    }
}

extern "C" void kernel_launch(void* const* d_in, const int* in_sizes, int n_in, void* d_out, int out_size, void* d_ws, size_t ws_size, hipStream_t stream) {
    static int grid = 0;
    if (grid == 0) {
        if (n_in != 31 || ws_size < WS_END || (size_t)out_size != O_END) { fprintf(stderr, "kernel_launch: unexpected shapes: n_in %d out %d ws %zu (need %zu)\n", n_in, out_size, ws_size, (size_t)WS_END); grid = -1; return; }
        int dev = 0, cus = 0, per_cu = 0;
        hipGetDevice(&dev); hipDeviceGetAttribute(&cus, hipDeviceAttributeMultiprocessorCount, dev);
        if (hipFuncSetAttribute((const void*)fwd_kernel, hipFuncAttributeMaxDynamicSharedMemorySize, LDS_BYTES) != hipSuccess) { fprintf(stderr, "kernel_launch: hipFuncSetAttribute failed\n"); grid = -1; return; }
        if (hipOccupancyMaxActiveBlocksPerMultiprocessor(&per_cu, (const void*)fwd_kernel, NTHREADS, LDS_BYTES) != hipSuccess || per_cu < 1) { fprintf(stderr, "kernel_launch: occupancy query says %d\n", per_cu); per_cu = 1; }
        (void)hipGetLastError();
        grid = cus * per_cu;
    }
    if (grid < 0) return;
    if (hipMemsetAsync((char*)d_ws + WS_CTR, 0, 256 + 16384, stream) != hipSuccess) { fprintf(stderr, "kernel_launch: memset failed\n"); return; }
    Params p{};
    for (int i = 0; i < 31; ++i) p.in[i] = (const float*)d_in[i];
    p.out = (float*)d_out; p.ws = (unsigned char*)d_ws; p.pad = 0;
#ifdef MULTI_LAUNCH
    p.coop = 0;
    for (int ph = 0; ph < 15; ++ph) { p.ph_lo = ph; p.ph_hi = ph + 1; hipLaunchKernelGGL(fwd_kernel, dim3(grid), dim3(NTHREADS), LDS_BYTES, stream, p); }
#else
    p.coop = 1; p.ph_lo = 0; p.ph_hi = 15;
    void* args[] = {&p};
    hipError_t e = hipLaunchCooperativeKernel((const void*)fwd_kernel, dim3(grid), dim3(NTHREADS), args, LDS_BYTES, stream);
    if (e != hipSuccess) fprintf(stderr, "cooperative launch failed: %s (grid %d)\n", hipGetErrorString(e), grid);
#endif
}
```
